# Optimizing an MI355X kernel written in HIP

```python
import jax, jax.numpy as jnp
from jax import lax
import numpy as np

D_MODEL = 1024
BATCH = 16
SEQ = 256
DEPTH = 2
DEC_BATCH = 4
DEC_SEQ = 2048
PAST_LEN = 512

GRID_W = 64
N_HEADS = 8
N_KV_HEADS = 2
HEAD_DIM = 64
GQA_GROUP = N_HEADS // N_KV_HEADS
ATTN_WIDTH = N_HEADS * HEAD_DIM
KV_WIDTH = N_KV_HEADS * HEAD_DIM
WINDOW = 128
BLOCK = 128
ROPE_BASE = 10000.0
CONV_WIDTH = 512
CHUNK = 128
GMLP_WIDTH = 1024
GMLP_GROUPS = 8
GMLP_GROUP_DIM = GMLP_WIDTH // GMLP_GROUPS
D_FF = 2816
EPS = 1e-6
NEG_INF = -1e30

N_EVEN = (DEPTH + 1) // 2
N_ODD = DEPTH // 2
N_ATTN_LAYERS = N_EVEN
EVEN_IN_WIDTH = ATTN_WIDTH + 2 * KV_WIDTH + 3 * CONV_WIDTH

kernel_name = 'hybrid_prefix_diffusion_step'


def rms_norm(x, g):
    xf = x.astype(jnp.float32)
    y = xf * lax.rsqrt(jnp.mean(xf * xf, axis=-1, keepdims=True) + EPS)
    return (y * g.astype(jnp.float32)).astype(x.dtype)


def dwconv3(x, w):
    xp = jnp.pad(x, ((0, 0), (1, 1), (0, 0)))
    return xp[:, :-2] * w[0] + xp[:, 1:-1] * w[1] + xp[:, 2:] * w[2]


def grid_angles(n_tokens):
    rows = n_tokens // GRID_W
    row = jnp.repeat(jnp.arange(rows), GRID_W).astype(jnp.float32)
    col = jnp.tile(jnp.arange(GRID_W), rows).astype(jnp.float32)
    n_freq = HEAD_DIM // 4
    inv = ROPE_BASE ** (-jnp.arange(n_freq, dtype=jnp.float32) / n_freq)
    return row[:, None] * inv, col[:, None] * inv


def rope_half(x, ang):
    n = ang.shape[-1]
    cos = jnp.cos(ang)[None, :, None, :]
    sin = jnp.sin(ang)[None, :, None, :]
    x1 = x[..., :n].astype(jnp.float32)
    x2 = x[..., n:].astype(jnp.float32)
    return jnp.concatenate([x1 * cos - x2 * sin, x2 * cos + x1 * sin], axis=-1).astype(x.dtype)


def axial_rope(x, row_ang, col_ang):
    half = HEAD_DIM // 2
    return jnp.concatenate([rope_half(x[..., :half], row_ang), rope_half(x[..., half:], col_ang)], axis=-1)


def ctx_self_attention(q, k, v, sink):
    B, S = q.shape[0], q.shape[1]
    nb = S // BLOCK
    qb = jnp.moveaxis(q.reshape(B, nb, BLOCK, N_KV_HEADS, GQA_GROUP, HEAD_DIM), 1, 0)
    sink_b = sink.astype(jnp.float32).reshape(1, N_KV_HEADS, GQA_GROUP, 1, 1)
    scale = HEAD_DIM ** -0.5

    def one_block(qi):
        s = jnp.einsum('bqhgd,bkhd->bhgqk', qi, k).astype(jnp.float32) * scale
        s = jnp.concatenate([jnp.broadcast_to(sink_b, s.shape[:-1] + (1,)), s], axis=-1)
        p = jax.nn.softmax(s, axis=-1)[..., 1:].astype(v.dtype)
        return jnp.einsum('bhgqk,bkhd->bqhgd', p, v)

    o = lax.map(one_block, qb)
    return jnp.moveaxis(o, 0, 1).reshape(B, S, ATTN_WIDTH)


def latent_window_attention(q, k, v, kc, vc, sink):
    B, L = q.shape[0], q.shape[1]
    nb = L // BLOCK
    scale = HEAD_DIM ** -0.5
    qb = q.reshape(B, nb, BLOCK, N_KV_HEADS, GQA_GROUP, HEAD_DIM)
    pad = ((0, 0), (BLOCK, BLOCK), (0, 0), (0, 0))
    idx = jnp.arange(nb)[:, None] * BLOCK + jnp.arange(3 * BLOCK)[None, :]
    kw = jnp.pad(k, pad)[:, idx]
    vw = jnp.pad(v, pad)[:, idx]
    qpos = jnp.arange(nb)[:, None, None] * BLOCK + jnp.arange(BLOCK)[None, :, None]
    kpos = idx[:, None, :] - BLOCK
    valid = (jnp.abs(qpos - kpos) <= WINDOW) & (kpos >= 0) & (kpos < L)
    s_loc = jnp.einsum('bnqhgd,bnkhd->bnhgqk', qb, kw).astype(jnp.float32) * scale
    s_loc = jnp.where(valid[None, :, None, None], s_loc, NEG_INF)
    s_ctx = jnp.einsum('bnqhgd,bkhd->bnhgqk', qb, kc).astype(jnp.float32) * scale
    sink_b = jnp.broadcast_to(sink.astype(jnp.float32).reshape(1, 1, N_KV_HEADS, GQA_GROUP, 1, 1),
                              s_loc.shape[:-1] + (1,))
    p = jax.nn.softmax(jnp.concatenate([sink_b, s_loc, s_ctx], axis=-1), axis=-1)
    p_loc = p[..., 1:1 + 3 * BLOCK].astype(v.dtype)
    p_ctx = p[..., 1 + 3 * BLOCK:].astype(v.dtype)
    o = (jnp.einsum('bnhgqk,bnkhd->bnqhgd', p_loc, vw)
         + jnp.einsum('bnhgqk,bkhd->bnqhgd', p_ctx, vc))
    return o.reshape(B, L, ATTN_WIDTH)


def even_projections(h, w_in, q_g, k_g):
    B, T = h.shape[0], h.shape[1]
    z = h @ w_in
    cuts = np.cumsum([ATTN_WIDTH, KV_WIDTH, KV_WIDTH, CONV_WIDTH, CONV_WIDTH]).tolist()
    q, k, v, b_gate, c_gate, hv = jnp.split(z, cuts, axis=-1)
    q = rms_norm(q.reshape(B, T, N_HEADS, HEAD_DIM), q_g)
    k = rms_norm(k.reshape(B, T, N_KV_HEADS, HEAD_DIM), k_g)
    v = v.reshape(B, T, N_KV_HEADS, HEAD_DIM)
    return q, k, v, b_gate, c_gate, hv


def short_conv(b_gate, c_gate, hv, w):
    return b_gate * dwconv3(c_gate * hv, w)


def gmlp_mixer(h, w_in, v_g, w_s, b_s, w_out):
    B, T = h.shape[0], h.shape[1]
    nc = T // CHUNK
    u, v = jnp.split(jax.nn.gelu(h @ w_in), 2, axis=-1)
    v = rms_norm(v, v_g).reshape(B, nc, CHUNK, GMLP_GROUPS, GMLP_GROUP_DIM)
    s = jnp.einsum('gts,bnsgc->bntgc', w_s, v) + b_s.T[:, :, None]
    return (u * s.reshape(B, T, GMLP_WIDTH)) @ w_out


def conv_ffn(h, w_up, conv_w, w_down):
    z = dwconv3(h @ w_up, conv_w)
    g, val = jnp.split(z, 2, axis=-1)
    return (jax.nn.silu(g) * val) @ w_down


def adaln(cond, w, b):
    m = jax.nn.silu(cond) @ w + b
    return [t[:, None, :] for t in jnp.split(m, 6, axis=-1)]


def modulate(x, g, shift, scale):
    return rms_norm(x, g) * (1 + scale) + shift


def setup_inputs(seed: int = 0) -> dict:
    key = jax.random.key(seed)
    ks = jax.random.split(key, 24)

    def nrm(k, shape, scale):
        return jax.random.normal(k, shape, jnp.float32) * scale

    D = D_MODEL
    return {
        'x_prompt': nrm(ks[0], (BATCH, SEQ, D), 1.0),
        'x_sample': nrm(ks[1], (DEC_BATCH, DEC_SEQ, D), 1.0),
        'cache_k': nrm(ks[2], (DEC_BATCH, N_ATTN_LAYERS, PAST_LEN, N_KV_HEADS, HEAD_DIM), 1.0),
        'cache_v': nrm(ks[3], (DEC_BATCH, N_ATTN_LAYERS, PAST_LEN, N_KV_HEADS, HEAD_DIM), 1.0),
        'c': nrm(ks[4], (DEC_BATCH, D), 1.0),
        'c_ctx': nrm(ks[5], (D,), 1.0),
        'ada_w': nrm(ks[6], (DEPTH, D, 6 * D), 0.5 * D ** -0.5),
        'ada_b': nrm(ks[7], (DEPTH, 6 * D), 0.02),
        'norm_mix_g': 1.0 + nrm(ks[8], (DEPTH, D), 0.05),
        'norm_ffn_g': 1.0 + nrm(ks[9], (DEPTH, D), 0.05),
        'w_in_even': nrm(ks[10], (N_EVEN, D, EVEN_IN_WIDTH), D ** -0.5),
        'q_norm_g': 1.0 + nrm(ks[11], (N_EVEN, HEAD_DIM), 0.05),
        'k_norm_g': 1.0 + nrm(ks[12], (N_EVEN, HEAD_DIM), 0.05),
        'sink_logit': nrm(ks[13], (N_EVEN, N_HEADS), 0.5),
        'short_conv_w': nrm(ks[14], (N_EVEN, 3, CONV_WIDTH), 3 ** -0.5),
        'w_out_even': nrm(ks[15], (N_EVEN, ATTN_WIDTH + CONV_WIDTH, D), (ATTN_WIDTH + CONV_WIDTH) ** -0.5),
        'w_in_odd': nrm(ks[16], (N_ODD, D, 2 * GMLP_WIDTH), D ** -0.5),
        'gmlp_norm_g': 1.0 + nrm(ks[17], (N_ODD, GMLP_WIDTH), 0.05),
        'w_spatial': nrm(ks[18], (N_ODD, GMLP_GROUPS, CHUNK, CHUNK), 0.5 * CHUNK ** -0.5),
        'b_spatial': 1.0 + nrm(ks[19], (N_ODD, GMLP_GROUPS, CHUNK), 0.1),
        'w_out_odd': nrm(ks[20], (N_ODD, GMLP_WIDTH, D), GMLP_WIDTH ** -0.5),
        'w_up': nrm(ks[21], (DEPTH, D, 2 * D_FF), D ** -0.5),
        'ffn_conv_w': nrm(ks[22], (DEPTH, 3, 2 * D_FF), 3 ** -0.5),
        'w_down': nrm(ks[23], (DEPTH, D_FF, D), D_FF ** -0.5),
    }


def reference(x_prompt, x_sample, cache_k, cache_v, c, c_ctx, ada_w, ada_b, norm_mix_g, norm_ffn_g,
              w_in_even, q_norm_g, k_norm_g, sink_logit, short_conv_w, w_out_even,
              w_in_odd, gmlp_norm_g, w_spatial, b_spatial, w_out_odd, w_up, ffn_conv_w, w_down):
    row_ang, col_ang = grid_angles(x_sample.shape[1])
    cond_ctx = c_ctx[None, :]
    xp, xs = x_prompt, x_sample
    new_k, new_v = [], []
    for l in range(DEPTH):
        shp, scp, gtp, shp2, scp2, gtp2 = adaln(cond_ctx, ada_w[l], ada_b[l])
        shs, scs, gts, shs2, scs2, gts2 = adaln(c, ada_w[l], ada_b[l])
        hp = modulate(xp, norm_mix_g[l], shp, scp)
        hs = modulate(xs, norm_mix_g[l], shs, scs)
        if l % 2 == 0:
            e = l // 2
            qp, kp, vp, bp, cp, up = even_projections(hp, w_in_even[e], q_norm_g[e], k_norm_g[e])
            mix_p = jnp.concatenate([ctx_self_attention(qp, kp, vp, sink_logit[e]),
                                     short_conv(bp, cp, up, short_conv_w[e])], axis=-1) @ w_out_even[e]
            new_k.append(kp)
            new_v.append(vp)
            qs, ks_, vs, bs, cs, us = even_projections(hs, w_in_even[e], q_norm_g[e], k_norm_g[e])
            qs = axial_rope(qs, row_ang, col_ang)
            ks_ = axial_rope(ks_, row_ang, col_ang)
            attn_s = latent_window_attention(qs, ks_, vs, cache_k[:, e], cache_v[:, e], sink_logit[e])
            mix_s = jnp.concatenate([attn_s, short_conv(bs, cs, us, short_conv_w[e])], axis=-1) @ w_out_even[e]
        else:
            o = l // 2
            mix_p = gmlp_mixer(hp, w_in_odd[o], gmlp_norm_g[o], w_spatial[o], b_spatial[o], w_out_odd[o])
            mix_s = gmlp_mixer(hs, w_in_odd[o], gmlp_norm_g[o], w_spatial[o], b_spatial[o], w_out_odd[o])
        xp = xp + gtp * mix_p
        xs = xs + gts * mix_s
        xp = xp + gtp2 * conv_ffn(modulate(xp, norm_ffn_g[l], shp2, scp2), w_up[l], ffn_conv_w[l], w_down[l])
        xs = xs + gts2 * conv_ffn(modulate(xs, norm_ffn_g[l], shs2, scs2), w_up[l], ffn_conv_w[l], w_down[l])
    new_cache_k = jnp.stack(new_k, axis=1)
    new_cache_v = jnp.stack(new_v, axis=1)
    return (xp, xs, new_cache_k, new_cache_v)
```

```cpp
#include <hip/hip_runtime.h>
#include <hip/hip_cooperative_groups.h>
#include <cstdio>
namespace cg = cooperative_groups;

#ifndef COOP
#define COOP 1
#endif
#ifndef REPMASK
#define REPMASK 0
#endif
#define REPS(k) (1 + ((REPMASK >> (k)) & 1))

#define LAS __attribute__((address_space(3)))
#define DI __device__ __forceinline__
typedef unsigned short bf16_t;
typedef short bf16x8 __attribute__((ext_vector_type(8)));
typedef float f32x4 __attribute__((ext_vector_type(4)));
typedef float f32x2 __attribute__((ext_vector_type(2)));
typedef float f32x16 __attribute__((ext_vector_type(16)));
typedef unsigned u32x4 __attribute__((ext_vector_type(4)));
typedef unsigned u32x2 __attribute__((ext_vector_type(2)));
typedef __bf16 bf2_t __attribute__((ext_vector_type(2)));

DI unsigned pk2(float a, float b) { f32x2 v = {a, b}; bf2_t r = __builtin_convertvector(v, bf2_t); return __builtin_bit_cast(unsigned, r); }
DI float bflo(unsigned w) { return __uint_as_float(w << 16); }
DI float bfhi(unsigned w) { return __uint_as_float(w & 0xffff0000u); }
DI bf16_t f2bf(float a) { return (bf16_t)(pk2(a, 0.f) & 0xffffu); }
DI void unpack8(const u32x4 w, float (&f)[8]) {
    f[0] = bflo(w.x); f[1] = bfhi(w.x); f[2] = bflo(w.y); f[3] = bfhi(w.y); f[4] = bflo(w.z); f[5] = bfhi(w.z); f[6] = bflo(w.w); f[7] = bfhi(w.w);
}
DI u32x4 pack8(const float (&f)[8]) { u32x4 w; w.x = pk2(f[0], f[1]); w.y = pk2(f[2], f[3]); w.z = pk2(f[4], f[5]); w.w = pk2(f[6], f[7]); return w; }

DI float xsum32(float x) { auto r = __builtin_amdgcn_permlane32_swap(__float_as_uint(x), __float_as_uint(x), false, false); return __uint_as_float(r[0]) + __uint_as_float(r[1]); }
DI float xmax32(float x) { auto r = __builtin_amdgcn_permlane32_swap(__float_as_uint(x), __float_as_uint(x), false, false); return fmaxf(__uint_as_float(r[0]), __uint_as_float(r[1])); }
DI float xsum16(float x) { auto r = __builtin_amdgcn_permlane16_swap(__float_as_uint(x), __float_as_uint(x), false, false); return __uint_as_float(r[0]) + __uint_as_float(r[1]); }
DI float wave_sum(float x) {
    x += __int_as_float(__builtin_amdgcn_update_dpp(0, __float_as_int(x), 0x128, 0xf, 0xf, false));
    x += __int_as_float(__builtin_amdgcn_update_dpp(0, __float_as_int(x), 0x124, 0xf, 0xf, false));
    x += __int_as_float(__builtin_amdgcn_update_dpp(0, __float_as_int(x), 0x122, 0xf, 0xf, false));
    x += __int_as_float(__builtin_amdgcn_update_dpp(0, __float_as_int(x), 0x121, 0xf, 0xf, false));
    return xsum32(xsum16(x));
}
#ifndef WT_STORES
#define WT_STORES 0
#endif
DI void st8(void* p, u32x2 v) {
#if WT_STORES
    __hip_atomic_store((unsigned long long*)p, ((unsigned long long)v.y << 32) | v.x, __ATOMIC_RELAXED, __HIP_MEMORY_SCOPE_AGENT);
#else
    *(u32x2*)p = v;
#endif
}
DI void st16(void* p, u32x4 v) {
#if WT_STORES
    u32x2 a = {v.x, v.y}, b = {v.z, v.w}; st8(p, a); st8((char*)p + 8, b);
#else
    *(u32x4*)p = v;
#endif
}
DI void st16f(void* p, f32x4 v) { u32x4 w = {__float_as_uint(v[0]), __float_as_uint(v[1]), __float_as_uint(v[2]), __float_as_uint(v[3])}; st16(p, w); }
#define OPAQUE_IDS() int tid_o = threadIdx.x; asm volatile("" : "+v"(tid_o)); int bid_o = blockIdx.x; asm volatile("" : "+s"(bid_o)); int gdim_o = gridDim.x; asm volatile("" : "+s"(gdim_o))
constexpr int MROWS = 12288, DM = 1024, MP = 4096;
constexpr int NT = 512;
constexpr int LDS_BYTES = 131072;
constexpr size_t OFF_WT_IN_EVEN = 0;
constexpr size_t OFF_WT_OUT_EVEN = OFF_WT_IN_EVEN + 2304ull * 1024 * 2;
constexpr size_t OFF_WT_IN_ODD = OFF_WT_OUT_EVEN + 1024ull * 1024 * 2;
constexpr size_t OFF_WT_OUT_ODD = OFF_WT_IN_ODD + 2048ull * 1024 * 2;
constexpr size_t OFF_WT_UP = OFF_WT_OUT_ODD + 1024ull * 1024 * 2;
constexpr size_t SZ_WT_UP = 5632ull * 1024 * 2;
constexpr size_t OFF_WT_DOWN = OFF_WT_UP + 2 * SZ_WT_UP;
constexpr size_t SZ_WT_DOWN = 1024ull * 2816 * 2;
constexpr size_t OFF_WSP = OFF_WT_DOWN + 2 * SZ_WT_DOWN;
constexpr size_t OFF_KC = OFF_WSP + 8ull * 128 * 128 * 2;
constexpr size_t OFF_VCT = OFF_KC + 4ull * 512 * 128 * 2;
constexpr size_t OFF_ROPE = OFF_VCT + 4ull * 512 * 128 * 2;
constexpr size_t OFF_MOD = OFF_ROPE + 64ull * 16 * 8;
constexpr size_t OFF_RSS = OFF_MOD + 2ull * 5 * 6144 * 4;
constexpr size_t OFF_GS = OFF_RSS + 4ull * 12288 * 4;
constexpr size_t OFF_SW = OFF_GS + 3ull * 5 * 1024 * 4;
constexpr size_t OFF_BAR = ((OFF_SW + 5ull * 13312 * 4 + 4095) / 4096) * 4096;
constexpr size_t BAR_BYTES = 16384;
constexpr size_t OFF_ACT = OFF_BAR + BAR_BYTES;
constexpr size_t OFF_U = OFF_ACT + (size_t)MROWS * 2816 * 2;
constexpr size_t OFF_Q = OFF_U;
constexpr size_t OFF_KB = OFF_Q + (size_t)MROWS * 512 * 2;
constexpr size_t OFF_VT = OFF_KB + (size_t)MROWS * 128 * 2;
constexpr size_t OFF_BCH = OFF_VT + (size_t)MROWS * 128 * 2;
constexpr size_t OFF_MIX = OFF_BCH + (size_t)MROWS * 1536 * 2;
constexpr size_t OFF_UG = OFF_U;
constexpr size_t OFF_V1 = OFF_UG + (size_t)MROWS * 1024 * 2;
constexpr size_t OFF_EDGE = OFF_U;
constexpr size_t OFF_H = OFF_U + 84ull * 1024 * 1024;
constexpr size_t OFF_XB = OFF_U + 109ull * 1024 * 1024;
static_assert(OFF_MIX + (size_t)MROWS * 1024 * 2 <= OFF_H && OFF_H + (size_t)MROWS * 1024 * 2 <= OFF_XB && OFF_XB + (size_t)MROWS * 1024 * 2 <= 256ull * 1024 * 1024, "layout");
static_assert(OFF_V1 + (size_t)MROWS * 1024 * 2 <= OFF_MIX, "layout");


struct KArgs { const float* in[24]; float* out; unsigned char* ws; int ph_lo, ph_hi; };
constexpr int PTAB_OFF = LDS_BYTES;
struct Params {
    LAS unsigned long long* tab;
    DI unsigned long long raw(int i) const { const unsigned long long v = tab[i]; const unsigned lo = __builtin_amdgcn_readfirstlane((unsigned)v), hi = __builtin_amdgcn_readfirstlane((unsigned)(v >> 32)); return ((unsigned long long)hi << 32) | lo; }
    DI const float* in(int i) const { return (const float*)(const __attribute__((address_space(1))) float*)raw(i); }
    DI float* outp() const { return (float*)(__attribute__((address_space(1))) float*)raw(24); }
    DI unsigned char* wsp() const { return (unsigned char*)(__attribute__((address_space(1))) unsigned char*)raw(25); }
};
#define x_prompt in(0)
#define x_sample in(1)
#define cache_k in(2)
#define cache_v in(3)
#define c_lat in(4)
#define c_ctx in(5)
#define ada_w in(6)
#define ada_b in(7)
#define norm_mix_g in(8)
#define norm_ffn_g in(9)
#define w_in_even in(10)
#define q_norm_g in(11)
#define k_norm_g in(12)
#define sink_logit in(13)
#define short_conv_w in(14)
#define w_out_even in(15)
#define w_in_odd in(16)
#define gmlp_norm_g in(17)
#define w_spatial in(18)
#define b_spatial in(19)
#define w_out_odd in(20)
#define w_up in(21)
#define ffn_conv_w in(22)
#define w_down in(23)

constexpr int BM = 256, BK = 64, HALF = 128, HTB = HALF * BK * 2, NXCD = 8, WGM = 8;
DI int lds_byte(int r, int c) { const int st = (r >> 4) * 2 + (c >> 5), rr = r & 15, cc = c & 31, ob = rr * 64 + cc * 2; return st * 1024 + (ob ^ (((ob >> 9) & 1) << 5)); }
DI void stage_rc(int b, int& R, int& C) { const int st = b / 1024, sb = b % 1024, swz = sb ^ (((sb >> 9) & 1) << 5); R = (st >> 1) * 16 + swz / 64; C = (st & 1) * 32 + (swz % 64) / 2; }
DI int perm32(int rho) { const int n = rho >> 4, i = rho & 15; return 8 * (i >> 2) + 4 * n + (i & 3); }
struct Unit { int pm, pn; };
struct Gemm { const bf16_t* A; const bf16_t* Bt; int M, N, K; };
struct StaticOrder {
    int nM, nN, nwg, G, c;
    DI void init(int M, int N, int G_, int c_) { nM = M / BM; nN = N / BM; nwg = nM * nN; G = G_; c = c_; }
    DI bool next(int i, Unit& u) const {
        const long L = (long)i * G + c; if (L >= nwg) return false;
        int wgid = (int)L; { const int q = nwg / NXCD, r = nwg % NXCD, xcd = wgid % NXCD, off = wgid / NXCD; wgid = (xcd < r ? xcd * (q + 1) : r * (q + 1) + (xcd - r) * q) + off; }
        const int nig = WGM * nN, gid = wgid / nig, fm = gid * WGM, gsz = (nM - fm) < WGM ? (nM - fm) : WGM;
        u.pm = fm + ((wgid % nig) % gsz); u.pn = (wgid % nig) / gsz; return true;
    }
};

template <class Epi>
DI void gemm_phase(LAS unsigned char* lds, const Gemm g, const Epi& E) {
    OPAQUE_IDS();
    const int tid = tid_o, wid = __builtin_amdgcn_readfirstlane(tid >> 6), lane = tid & 63, wr = wid >> 2, wc = wid & 3, fr = lane & 15, fq = lane >> 4;
    const int K = g.K, nt = K / BK;
    StaticOrder S; S.init(g.M, g.N, gdim_o, bid_o);
    unsigned voffA[2], voffB[2];
#pragma unroll
    for (int i = 0; i < 2; ++i) { int R, C; stage_rc(tid * 16 + i * 8192, R, C); const int Rb = Epi::PERM ? ((R & ~31) + perm32(R & 31)) : R;
        voffA[i] = (unsigned)(R * K + C) * 2u; voffB[i] = (unsigned)(Rb * K + C) * 2u; }
    const size_t kstep = (size_t)(BK * 2);
    const size_t hstep = (size_t)HALF * K * 2;
    const size_t tstep = 2 * hstep;
    const unsigned ldsw = (unsigned)wid * 1024u;
    const int aoff = lds_byte(wr * 64 + fr, fq * 8), boff = lds_byte(wc * 32 + fr, fq * 8);
#define PG8_SA(b, h) (((b) * 2 + (h)) * HTB)
#define PG8_SB(b, h) ((4 + (b) * 2 + (h)) * HTB)
#define PG8_STAGE(bufoff, gbase, voff) do { _Pragma("unroll") for (int _i = 0; _i < 2; ++_i) \
        __builtin_amdgcn_global_load_lds((const unsigned*)((const char*)(gbase) + (voff)[_i]), (LAS unsigned*)(lds + (bufoff) + ldsw + _i * 8192), 16, 0, 0); } while (0)
#define PG8_LDA(dst, b, h) do { _Pragma("unroll") for (int m = 0; m < 4; ++m) _Pragma("unroll") for (int k = 0; k < 2; ++k) dst[m][k] = *(const LAS bf16x8*)(lds + PG8_SA(b, h) + aoff + m * 2048 + k * 1024); } while (0)
#define PG8_LDB(dst, b, h) do { _Pragma("unroll") for (int n = 0; n < 2; ++n) _Pragma("unroll") for (int k = 0; k < 2; ++k) dst[n][k] = *(const LAS bf16x8*)(lds + PG8_SB(b, h) + boff + n * 2048 + k * 1024); } while (0)
#define PG8_MMA(ai, bj, At, Bt) do { __builtin_amdgcn_s_setprio(1); _Pragma("unroll") for (int m = 0; m < 4; ++m) _Pragma("unroll") for (int n = 0; n < 2; ++n) _Pragma("unroll") for (int k = 0; k < 2; ++k) \
        acc[ai][bj][m][n] = __builtin_amdgcn_mfma_f32_16x16x32_bf16(Bt[n][k], At[m][k], acc[ai][bj][m][n], 0, 0, 0); __builtin_amdgcn_s_setprio(0); } while (0)
#define PG8_WAIT_V(n) asm volatile("s_waitcnt vmcnt(" #n ")" ::: "memory")
#define PG8_WAIT_L(n) asm volatile("s_waitcnt lgkmcnt(" #n ")" ::: "memory")
#define PG8_BAR __builtin_amdgcn_s_barrier()
#define PG8_SCHED __builtin_amdgcn_sched_barrier(0)
    Unit cur, nxt; int ui = 0;
    if (!S.next(0, cur)) return;
    f32x4 acc[2][2][4][2];
#pragma unroll
    for (int a = 0; a < 2; ++a)
#pragma unroll
        for (int b = 0; b < 2; ++b)
#pragma unroll
            for (int m = 0; m < 4; ++m)
#pragma unroll
                for (int n = 0; n < 2; ++n) acc[a][b][m][n] = (f32x4){0.f, 0.f, 0.f, 0.f};
    bf16x8 At[4][2], B0[2][2], B1[2][2];
    const char* cA = (const char*)g.A + (size_t)cur.pm * tstep; const char* cB = (const char*)g.Bt + (size_t)cur.pn * tstep;
    PG8_STAGE(PG8_SB(0, 0), cB, voffB); PG8_STAGE(PG8_SA(0, 0), cA, voffA); PG8_STAGE(PG8_SB(0, 1), cB + hstep, voffB); PG8_STAGE(PG8_SA(0, 1), cA + hstep, voffA);
    if (wr == 1) PG8_BAR;
    PG8_WAIT_V(4); PG8_BAR;
    PG8_STAGE(PG8_SB(1, 0), cB + kstep, voffB); PG8_STAGE(PG8_SA(1, 0), cA + kstep, voffA); PG8_STAGE(PG8_SB(1, 1), cB + hstep + kstep, voffB);
    PG8_WAIT_V(6); PG8_BAR;
    for (;;) {
        const bool has_next = S.next(ui + 1, nxt);
        const char* nA = has_next ? (const char*)g.A + (size_t)nxt.pm * tstep : cA; const char* nB = has_next ? (const char*)g.Bt + (size_t)nxt.pn * tstep : cB;
        for (int t = 0; t < nt; t += 2) {
            const bool last = (t == nt - 2);
            const char* a1 = cA + (size_t)(t + 1) * kstep;
            const char* a2 = last ? nA : cA + (size_t)(t + 2) * kstep; const char* b2 = last ? nB : cB + (size_t)(t + 2) * kstep;
            const char* a3 = a2 + kstep; const char* b3 = b2 + kstep;
            PG8_LDB(B0, 0, 0); PG8_SCHED; PG8_LDA(At, 0, 0); PG8_STAGE(PG8_SA(1, 1), a1 + hstep, voffA);
            PG8_WAIT_L(8); PG8_BAR; PG8_WAIT_L(0); PG8_MMA(0, 0, At, B0); PG8_BAR; PG8_SCHED;
            PG8_LDB(B1, 0, 1); PG8_STAGE(PG8_SB(0, 0), b2, voffB);
            PG8_BAR; PG8_WAIT_L(0); PG8_MMA(0, 1, At, B1); PG8_BAR;
            PG8_LDA(At, 0, 1); PG8_STAGE(PG8_SA(0, 0), a2, voffA);
            PG8_BAR; PG8_WAIT_L(0); PG8_MMA(1, 0, At, B0); PG8_BAR; PG8_SCHED;
            PG8_STAGE(PG8_SB(0, 1), b2 + hstep, voffB);
            PG8_WAIT_V(6); PG8_BAR; PG8_MMA(1, 1, At, B1); PG8_BAR;
            PG8_LDB(B0, 1, 0); PG8_SCHED; PG8_LDA(At, 1, 0); PG8_STAGE(PG8_SA(0, 1), a2 + hstep, voffA);
            PG8_WAIT_L(8); PG8_BAR; PG8_WAIT_L(0); PG8_MMA(0, 0, At, B0); PG8_BAR; PG8_SCHED;
            PG8_LDB(B1, 1, 1); PG8_STAGE(PG8_SB(1, 0), b3, voffB);
            PG8_BAR; PG8_WAIT_L(0); PG8_MMA(0, 1, At, B1); PG8_BAR;
            PG8_LDA(At, 1, 1); PG8_STAGE(PG8_SA(1, 0), a3, voffA);
            PG8_BAR; PG8_WAIT_L(0); PG8_MMA(1, 0, At, B0); PG8_BAR; PG8_SCHED;
            PG8_STAGE(PG8_SB(1, 1), b3 + hstep, voffB);
            PG8_WAIT_V(6); PG8_BAR; PG8_MMA(1, 1, At, B1); PG8_BAR;
        }
        E(acc, cur, wr, wc, fr, fq);
        if (!has_next) break;
#pragma unroll
        for (int a = 0; a < 2; ++a)
#pragma unroll
            for (int b = 0; b < 2; ++b)
#pragma unroll
                for (int m = 0; m < 4; ++m)
#pragma unroll
                    for (int n = 0; n < 2; ++n) acc[a][b][m][n] = (f32x4){0.f, 0.f, 0.f, 0.f};
        cur = nxt; cA = nA; cB = nB; ++ui;
    }
    PG8_WAIT_V(0);
    if (wr == 0) PG8_BAR;
    PG8_BAR;
#undef PG8_SA
#undef PG8_SB
#undef PG8_STAGE
#undef PG8_LDA
#undef PG8_LDB
#undef PG8_MMA
#undef PG8_WAIT_V
#undef PG8_WAIT_L
#undef PG8_BAR
#undef PG8_SCHED
}

struct EpiInEven {
    static constexpr bool PERM = false;
    bf16_t *Q, *Kb, *Vt, *BCH; float *outK, *outV; const float *qg, *kg; const f32x2* rope;
    DI void operator()(f32x4 (&acc)[2][2][4][2], const Unit& u, int wr, int wc, int fr_, int fq_) const {
        int fr = fr_, fq = fq_; asm volatile("" : "+v"(fr), "+v"(fq));
        const int row0 = u.pm * BM + wr * 64 + fr;
        const bool samp = (u.pm >= 16);
        if (u.pn >= 3) {
            const int cb = u.pn * 256 - 768 + wc * 64 + 8 * fq;
#pragma unroll
            for (int ai = 0; ai < 2; ++ai)
#pragma unroll
                for (int m = 0; m < 4; ++m) { bf16_t* rp = BCH + (size_t)(row0 + ai * HALF + m * 16) * 1536 + cb;
#pragma unroll
                    for (int bj = 0; bj < 2; ++bj) { const f32x4 v0 = acc[ai][bj][m][0], v1 = acc[ai][bj][m][1];
                        u32x4 w; w.x = pk2(v0[0], v0[1]); w.y = pk2(v0[2], v0[3]); w.z = pk2(v1[0], v1[1]); w.w = pk2(v1[2], v1[3]); *(u32x4*)(rp + 32 * bj) = w; } }
            return;
        }
        const bool isv = (u.pn == 2 && wc >= 2);
        if (!isv) {
            const bool isq = u.pn < 2;
            const float* gsrc = isq ? qg : kg;
            f32x4 gg[2][2];
#pragma unroll
            for (int bj = 0; bj < 2; ++bj)
#pragma unroll
                for (int n = 0; n < 2; ++n) gg[bj][n] = *(const f32x4*)(gsrc + 32 * bj + 16 * n + 4 * fq);
            const int head = isq ? u.pn * 4 + wc : wc;
#pragma unroll
            for (int ai = 0; ai < 2; ++ai)
#pragma unroll
                for (int m = 0; m < 4; ++m) {
                    const int row = row0 + ai * HALF + m * 16;
                    float ss = 0.f;
#pragma unroll
                    for (int bj = 0; bj < 2; ++bj)
#pragma unroll
                        for (int n = 0; n < 2; ++n) { const f32x4 v = acc[ai][bj][m][n]; ss += (v[0] * v[0] + v[1] * v[1]) + (v[2] * v[2] + v[3] * v[3]); }
                    ss = xsum32(xsum16(ss));
                    const float rstd = rsqrtf(ss * (1.0f / 64.0f) + 1e-6f);
                    f32x4 v[2][2];
#pragma unroll
                    for (int bj = 0; bj < 2; ++bj)
#pragma unroll
                        for (int n = 0; n < 2; ++n) v[bj][n] = acc[ai][bj][m][n] * rstd * gg[bj][n];
                    if (samp) {
                        const int t = (row - MP) & 2047; const int pr = t >> 6, pc = t & 63;
#pragma unroll
                        for (int bj = 0; bj < 2; ++bj) {
                            const int pos = bj ? pc : pr; const f32x4* rp = (const f32x4*)(rope + pos * 16 + 4 * fq);
                            const f32x4 c01 = rp[0], c23 = rp[1];
                            const float cs[4] = {c01[0], c01[2], c23[0], c23[2]}, sn[4] = {c01[1], c01[3], c23[1], c23[3]};
#pragma unroll
                            for (int e = 0; e < 4; ++e) { const float x1 = v[bj][0][e], x2 = v[bj][1][e]; v[bj][0][e] = x1 * cs[e] - x2 * sn[e]; v[bj][1][e] = x2 * cs[e] + x1 * sn[e]; }
                        }
                    }
                    if (isq) { bf16_t* dp = Q + (size_t)row * 512 + head * 64 + 4 * fq;
#pragma unroll
                        for (int bj = 0; bj < 2; ++bj)
#pragma unroll
                            for (int n = 0; n < 2; ++n) { u32x2 w; w.x = pk2(v[bj][n][0], v[bj][n][1]); w.y = pk2(v[bj][n][2], v[bj][n][3]); st8(dp + 32 * bj + 16 * n, w); } }
                    else {
                        size_t cb; int t;
                        if (!samp) { t = row & 255; cb = (size_t)(((row >> 8) * 2 + head) * 8 + (t >> 5)) * 2048; }
                        else { const int r2 = row - MP; t = r2 & 2047; cb = 524288 + (size_t)(((r2 >> 11) * 2 + head) * 64 + (t >> 5)) * 2048; }
                        bf16_t* dp = Kb + cb + ((fq >> 1) * 32 + (t & 31)) * 8 + 4 * (fq & 1);
#pragma unroll
                        for (int bj = 0; bj < 2; ++bj)
#pragma unroll
                            for (int n = 0; n < 2; ++n) { u32x2 w; w.x = pk2(v[bj][n][0], v[bj][n][1]); w.y = pk2(v[bj][n][2], v[bj][n][3]); *(u32x2*)(dp + (2 * bj + n) * 512) = w; } }
                    if (!isq && !samp) { float* op = outK + ((size_t)row * 2 + head) * 64 + 4 * fq;
#pragma unroll
                        for (int bj = 0; bj < 2; ++bj)
#pragma unroll
                            for (int n = 0; n < 2; ++n) *(f32x4*)(op + 32 * bj + 16 * n) = v[bj][n]; }
                }
        } else {
            const int hv = wc - 2;
#pragma unroll
            for (int ai = 0; ai < 2; ++ai)
#pragma unroll
                for (int m = 0; m < 4; ++m) {
                    const int row = row0 + ai * HALF + m * 16;
                    bf16_t* vb; size_t vs;
                    if (!samp) {
                        float* op = outV + ((size_t)row * 2 + hv) * 64 + 4 * fq;
#pragma unroll
                        for (int bj = 0; bj < 2; ++bj)
#pragma unroll
                            for (int n = 0; n < 2; ++n) *(f32x4*)(op + 32 * bj + 16 * n) = acc[ai][bj][m][n];
                        const int t = row & 255; vb = Vt + (size_t)(((row >> 8) * 2 + hv) * 8 + (t >> 5)) * 2048; vs = t & 31;
                    } else { const int r2 = row - MP; const int t = r2 & 2047; vb = Vt + 524288 + (size_t)(((r2 >> 11) * 2 + hv) * 64 + (t >> 5)) * 2048; vs = t & 31; }
                    { const int tk = (int)vs; const int ks = tk >> 4, kk = tk & 15; vb += (ks * 64 + ((kk >> 2) & 1) * 32) * 8 + 4 * (kk >> 3) + (kk & 3); }
#pragma unroll
                    for (int bj = 0; bj < 2; ++bj)
#pragma unroll
                        for (int n = 0; n < 2; ++n)
#pragma unroll
                            for (int e = 0; e < 4; ++e) vb[(bj * 128 + 16 * n + 4 * fq + e) * 8] = f2bf(acc[ai][bj][m][n][e]);
                }
        }
    }
};

struct EpiResid {
    static constexpr bool PERM = true;
    const float* xp; const float* xs; const bf16_t* xb;
    float* out; bf16_t* outb;
    const float* gate;
    bf16_t* Aout; const float* gs; float* rss;
    DI void operator()(f32x4 (&acc)[2][2][4][2], const Unit& u, int wr, int wc, int fr_, int fq_) const {
        int fr = fr_, fq = fq_; asm volatile("" : "+v"(fr), "+v"(fq));
        const int row0 = u.pm * BM + wr * 64 + fr, col0 = u.pn * BM + wc * 32 + 8 * fq;
        const int cond = u.pm < 16 ? 0 : 1 + ((u.pm - 16) >> 3);
        const float* gp = gate + cond * 6144 + col0;
        f32x4 gv[2][2], gsv[2][2];
#pragma unroll
        for (int bj = 0; bj < 2; ++bj)
#pragma unroll
            for (int n = 0; n < 2; ++n) { gv[bj][n] = *(const f32x4*)(gp + bj * HALF + 4 * n); gsv[bj][n] = Aout ? *(const f32x4*)(gs + cond * 1024 + col0 + bj * HALF + 4 * n) : (f32x4){0.f, 0.f, 0.f, 0.f}; }
#pragma unroll
        for (int ai = 0; ai < 2; ++ai)
#pragma unroll
            for (int m = 0; m < 4; ++m) {
                const int row = row0 + ai * HALF + m * 16;
                const size_t ro = (size_t)row * DM + col0;
                const float* xin = (row < MP ? xp + (size_t)row * DM : xs + (size_t)(row - MP) * DM) + col0;
                float ss = 0.f;
#pragma unroll
                for (int bj = 0; bj < 2; ++bj) { const int co = bj * HALF;
                    f32x4 x0, x1;
                    if (xb) { const u32x4 w = *(const u32x4*)(xb + ro + co); x0 = (f32x4){bflo(w.x), bfhi(w.x), bflo(w.y), bfhi(w.y)}; x1 = (f32x4){bflo(w.z), bfhi(w.z), bflo(w.w), bfhi(w.w)}; }
                    else { x0 = *(const f32x4*)(xin + co); x1 = *(const f32x4*)(xin + co + 4); }
                    const f32x4 n0 = x0 + gv[bj][0] * acc[ai][bj][m][0], n1 = x1 + gv[bj][1] * acc[ai][bj][m][1];
                    if (outb) { u32x4 w; w.x = pk2(n0[0], n0[1]); w.y = pk2(n0[2], n0[3]); w.z = pk2(n1[0], n1[1]); w.w = pk2(n1[2], n1[3]); *(u32x4*)(outb + ro + co) = w; }
                    else { *(f32x4*)(out + ro + co) = n0; *(f32x4*)(out + ro + co + 4) = n1; }
                    if (Aout) { ss += (n0[0] * n0[0] + n0[1] * n0[1]) + (n0[2] * n0[2] + n0[3] * n0[3]) + (n1[0] * n1[0] + n1[1] * n1[1]) + (n1[2] * n1[2] + n1[3] * n1[3]);
                        const f32x4 a0 = n0 * gsv[bj][0], a1 = n1 * gsv[bj][1];
                        u32x4 w; w.x = pk2(a0[0], a0[1]); w.y = pk2(a0[2], a0[3]); w.z = pk2(a1[0], a1[1]); w.w = pk2(a1[2], a1[3]); *(u32x4*)(Aout + ro + co) = w; } }
                if (Aout) { ss = xsum32(xsum16(ss)); if (fq == 0) atomicAdd(rss + row, ss); }
            }
    }
};

DI float silu_f(float x) { return x * __builtin_amdgcn_rcpf(1.0f + __builtin_amdgcn_exp2f(-1.4426950408889634f * x)); }
#define DPP_SHR1(x)  __int_as_float(__builtin_amdgcn_update_dpp(0, __float_as_int(x), 0x111, 0xf, 0xf, true))
#define DPP_SHL1(x)  __int_as_float(__builtin_amdgcn_update_dpp(0, __float_as_int(x), 0x101, 0xf, 0xf, true))
#define DPP_SHL15(x) __int_as_float(__builtin_amdgcn_update_dpp(0, __float_as_int(x), 0x10f, 0xf, 0xf, true))
#define DPP_SHR15(x) __int_as_float(__builtin_amdgcn_update_dpp(0, __float_as_int(x), 0x11f, 0xf, 0xf, true))
struct EpiUpConv {
    static constexpr bool PERM = true;
    bf16_t* ACT; bf16_t* EDGE; const float* cw;
    const float* rss; const float* sw;
    DI void operator()(f32x4 (&acc)[2][2][4][2], const Unit& u, int wr, int wc, int fr_, int fq_) const {
        int fr = fr_, fq = fq_; asm volatile("" : "+v"(fr), "+v"(fq));
        {
            const int cond = u.pm < 16 ? 0 : 1 + ((u.pm - 16) >> 3);
            const float* sp = sw + (size_t)cond * 5632 + u.pn * 256 + wc * 32 + 8 * fq;
            f32x4 swv[2][2];
#pragma unroll
            for (int bj = 0; bj < 2; ++bj)
#pragma unroll
                for (int n = 0; n < 2; ++n) swv[bj][n] = *(const f32x4*)(sp + bj * HALF + 4 * n);
#pragma unroll
            for (int ai = 0; ai < 2; ++ai)
#pragma unroll
                for (int m = 0; m < 4; ++m) { const float rstd = rsqrtf(rss[u.pm * BM + ai * HALF + wr * 64 + 16 * m + fr] * (1.0f / 1024.0f) + 1e-6f);
#pragma unroll
                    for (int bj = 0; bj < 2; ++bj)
#pragma unroll
                        for (int n = 0; n < 2; ++n) acc[ai][bj][m][n] = acc[ai][bj][m][n] * rstd + swv[bj][n]; }
        }
#pragma unroll
        for (int n = 0; n < 2; ++n) {
            const int ch0 = u.pn * 128 + wc * 32 + 8 * fq + 4 * n;
            f32x4 wg[3], wv[3];
#pragma unroll
            for (int tp = 0; tp < 3; ++tp) { wg[tp] = *(const f32x4*)(cw + tp * 5632 + ch0); wv[tp] = *(const f32x4*)(cw + tp * 5632 + 2816 + ch0); }
#pragma unroll
            for (int ai = 0; ai < 2; ++ai) {
                const int rbase = u.pm * BM + ai * HALF + wr * 64;
#pragma unroll
                for (int m = 0; m < 4; ++m) {
                    const int row = rbase + 16 * m + fr;
                    float o[4];
#pragma unroll
                    for (int e = 0; e < 4; ++e) {
                        float cv[2];
#pragma unroll
                        for (int bj = 0; bj < 2; ++bj) {
                            const float x = acc[ai][bj][m][n][e];
                            const float w0 = bj ? wv[0][e] : wg[0][e], w1 = bj ? wv[1][e] : wg[1][e], w2 = bj ? wv[2][e] : wg[2][e];
                            float c = w1 * x;
                            c = __builtin_fmaf(DPP_SHR1(x), w0, c);
                            c = __builtin_fmaf(DPP_SHL1(x), w2, c);
                            if (m > 0) c = __builtin_fmaf(DPP_SHL15(acc[ai][bj][m > 0 ? m - 1 : 0][n][e]), w0, c);
                            if (m < 3) c = __builtin_fmaf(DPP_SHR15(acc[ai][bj][m < 3 ? m + 1 : 3][n][e]), w2, c);
                            cv[bj] = c;
                        }
                        o[e] = cv[0] * cv[1] * __builtin_amdgcn_rcpf(1.0f + __builtin_amdgcn_exp2f(-1.4426950408889634f * cv[0]));
                    }
                    const bool edge = (m == 0 && fr == 0) || (m == 3 && fr == 15);
                    if (!edge) { u32x2 w; w.x = pk2(o[0], o[1]); w.y = pk2(o[2], o[3]); st8(ACT + (size_t)row * 2816 + ch0, w); }
                    if ((m == 0 && fr < 2) || (m == 3 && fr >= 14)) {
                        const int slot = (m == 0) ? fr : fr - 12;
                        bf16_t* ep = EDGE + (size_t)((row >> 6) * 4 + slot) * 5632 + ch0;
                        const f32x4 g0 = acc[ai][0][m][n], v0 = acc[ai][1][m][n];
                        u32x2 w; w.x = pk2(g0[0], g0[1]); w.y = pk2(g0[2], g0[3]); *(u32x2*)ep = w;
                        u32x2 w2; w2.x = pk2(v0[0], v0[1]); w2.y = pk2(v0[2], v0[3]); *(u32x2*)(ep + 2816) = w2;
                    }
                }
            }
        }
    }
};

DI float gelu_tanh(float x) {
    const float y = (1.5957691216057308f * 1.4426950408889634f) * (x + 0.044715f * x * x * x);
    return x * __builtin_amdgcn_rcpf(1.0f + __builtin_amdgcn_exp2f(-y));
}
struct EpiInOdd {
    static constexpr bool PERM = true;
    bf16_t *UG, *V1; float* rss; const float* rssx; const float* sw;
    DI void operator()(f32x4 (&acc)[2][2][4][2], const Unit& u, int wr, int wc, int fr_, int fq_) const {
        int fr = fr_, fq = fq_; asm volatile("" : "+v"(fr), "+v"(fq));
        const int row0 = u.pm * BM + wr * 64 + fr, col0 = (u.pn & 3) * BM + wc * 32 + 8 * fq;
        const bool isv = u.pn >= 4;
        bf16_t* dst = isv ? V1 : UG;
        const int cond = u.pm < 16 ? 0 : 1 + ((u.pm - 16) >> 3);
        const float* sp = sw + (size_t)cond * 2048 + u.pn * 256 + wc * 32 + 8 * fq;
        f32x4 swv[2][2];
#pragma unroll
        for (int bj = 0; bj < 2; ++bj)
#pragma unroll
            for (int n = 0; n < 2; ++n) swv[bj][n] = *(const f32x4*)(sp + bj * HALF + 4 * n);
#pragma unroll
        for (int ai = 0; ai < 2; ++ai)
#pragma unroll
            for (int m = 0; m < 4; ++m) { const int row = row0 + ai * HALF + m * 16; bf16_t* rp = dst + (size_t)row * 1024 + col0; float ss = 0.f;
                const float rstd = rsqrtf(rssx[row] * (1.0f / 1024.0f) + 1e-6f);
#pragma unroll
                for (int bj = 0; bj < 2; ++bj) { f32x4 v0 = acc[ai][bj][m][0] * rstd + swv[bj][0], v1 = acc[ai][bj][m][1] * rstd + swv[bj][1];
#pragma unroll
                    for (int e = 0; e < 4; ++e) { v0[e] = gelu_tanh(v0[e]); v1[e] = gelu_tanh(v1[e]); ss += v0[e] * v0[e] + v1[e] * v1[e]; }
                    u32x4 w; w.x = pk2(v0[0], v0[1]); w.y = pk2(v0[2], v0[3]); w.z = pk2(v1[0], v1[1]); w.w = pk2(v1[2], v1[3]); st16(rp + bj * HALF, w); }
                if (isv) { ss = xsum32(xsum16(ss)); if (fq == 0) atomicAdd(rss + row, ss); }
            }
    }
};


DI void adaln_prep(const Params& p, LAS unsigned char* lds, int tid) {
    LAS float* S = (LAS float*)(lds + 66048);
    for (int i = tid; i < 5 * 1024; i += NT) { const int cd = i >> 10, k = i & 1023; const float v = cd == 0 ? p.c_ctx[k] : p.c_lat[(cd - 1) * 1024 + k]; S[i] = silu_f(v); }
    __syncthreads();
}
DI void adaln_task(const Params& p, LAS unsigned char* lds, int tid, int task) {
    LAS float* S = (LAS float*)(lds + 66048);
    LAS float* P = (LAS float*)(lds + 66048 + 20480);
    float* mod = (float*)(p.wsp() + OFF_MOD);
    const int cgp = tid & 7, kg = tid >> 3;
    const int l = task / 192, cc = task % 192;
    const float* wp = p.ada_w + ((size_t)l * 1024 + kg * 16) * 6144 + cc * 32 + 4 * cgp;
    f32x4 a[5];
#pragma unroll
    for (int cd = 0; cd < 5; ++cd) a[cd] = (f32x4){0.f, 0.f, 0.f, 0.f};
#pragma unroll
    for (int kk = 0; kk < 16; ++kk) { const f32x4 w = __builtin_nontemporal_load((const f32x4*)(wp + (size_t)kk * 6144));
#pragma unroll
        for (int cd = 0; cd < 5; ++cd) a[cd] += w * S[cd * 1024 + kg * 16 + kk]; }
#pragma unroll
    for (int cd = 0; cd < 5; ++cd)
#pragma unroll
        for (int e = 0; e < 4; ++e) P[(kg * 8 + cgp) * 20 + cd * 4 + e] = a[cd][e];
    __syncthreads();
    if (tid < 160) { const int cd = tid >> 5, col = tid & 31, cg2 = col >> 2, e = col & 3; float sacc = 0.f;
        for (int k2 = 0; k2 < 64; ++k2) sacc += P[(k2 * 8 + cg2) * 20 + cd * 4 + e];
        mod[(size_t)(l * 5 + cd) * 6144 + cc * 32 + col] = sacc + p.ada_b[l * 6144 + cc * 32 + col]; }
    __syncthreads();
}
DI void transpose_tile(const Params& p, LAS unsigned char* lds, int tid, int tile) {
    unsigned char* ws = p.wsp();
    LAS float* T = (LAS float*)lds;
    int t = tile; const float* src; bf16_t* dst; int K, N, perm = 0;
    if (t < 144) { src = p.w_in_even; dst = (bf16_t*)(ws + OFF_WT_IN_EVEN); K = 1024; N = 2304; perm = 1; }
    else if ((t -= 144) < 64) { src = p.w_out_even; dst = (bf16_t*)(ws + OFF_WT_OUT_EVEN); K = 1024; N = 1024; }
    else if ((t -= 64) < 128) { src = p.w_in_odd; dst = (bf16_t*)(ws + OFF_WT_IN_ODD); K = 1024; N = 2048; }
    else if ((t -= 128) < 64) { src = p.w_out_odd; dst = (bf16_t*)(ws + OFF_WT_OUT_ODD); K = 1024; N = 1024; }
    else if ((t -= 64) < 352) { src = p.w_up; dst = (bf16_t*)(ws + OFF_WT_UP); K = 1024; N = 5632; perm = 2; }
    else if ((t -= 352) < 352) { src = p.w_up + (size_t)1024 * 5632; dst = (bf16_t*)(ws + OFF_WT_UP + SZ_WT_UP); K = 1024; N = 5632; perm = 2; }
    else if ((t -= 352) < 176) { src = p.w_down; dst = (bf16_t*)(ws + OFF_WT_DOWN); K = 2816; N = 1024; }
    else { t -= 176; src = p.w_down + (size_t)2816 * 1024; dst = (bf16_t*)(ws + OFF_WT_DOWN + SZ_WT_DOWN); K = 2816; N = 1024; }
    const int tn = N >> 8; const int tk = t / tn, tnn = t - tk * tn; const int k0 = tk * 64, n0 = tnn * 256;
    {
        const int c4 = tid & 63, r0 = tid >> 6;
        f32x4 v[8];
#pragma unroll
        for (int i = 0; i < 8; ++i) v[i] = __builtin_nontemporal_load((const f32x4*)(src + (size_t)(k0 + r0 + 8 * i) * N + n0 + 4 * c4));
#pragma unroll
        for (int i = 0; i < 8; ++i) { LAS float* tp = T + (r0 + 8 * i) * 257 + 4 * c4; tp[0] = v[i][0]; tp[1] = v[i][1]; tp[2] = v[i][2]; tp[3] = v[i][3]; }
    }
    __syncthreads();
    {
        const int n = tid & 255, kh = tid >> 8;
        const int oc = n0 + n;
        int gcol = oc;
        if (perm == 1) { const int w32 = oc & 31;
            const int in32 = oc >= 768 ? 16 * ((w32 >> 2) & 1) + 4 * (w32 >> 3) + (w32 & 3) : w32;
            gcol = (oc & ~255) + ((oc >> 5) & 1) * 128 + ((oc >> 6) & 3) * 32 + in32; }
        if (perm == 2) { const int isv = oc >= 2816, j = isv ? oc - 2816 : oc; gcol = (j >> 7) * 256 + isv * 128 + (j & 127); }
        bf16_t* dp = dst + (size_t)gcol * K + k0 + 32 * kh;
#pragma unroll
        for (int q = 0; q < 4; ++q) { float f[8];
#pragma unroll
            for (int j = 0; j < 8; ++j) f[j] = T[(32 * kh + 8 * q + j) * 257 + n];
            *(u32x4*)(dp + 8 * q) = pack8(f); }
    }
    __syncthreads();
}
DI void wspatial_job(const Params& p, int tid, int j) {
    bf16_t* wsp = (bf16_t*)(p.wsp() + OFF_WSP);
    for (int i = j * 2048 + tid; i < (j + 1) * 2048; i += NT) { const f32x4 a = *(const f32x4*)(p.w_spatial + (size_t)i * 8), b = *(const f32x4*)(p.w_spatial + (size_t)i * 8 + 4);
        u32x4 w; w.x = pk2(a[0], a[1]); w.y = pk2(a[2], a[3]); w.z = pk2(b[0], b[1]); w.w = pk2(b[2], b[3]); *(u32x4*)(wsp + (size_t)i * 8) = w; }
}
DI void sw_chunk(const Params& p, int chunk, int lane) {
    unsigned char* ws = p.wsp();
    const float* mod = (const float*)(ws + OFF_MOD); float* SW = (float*)(ws + OFF_SW);
    const int r0 = chunk * 8;
    const bf16_t* wt; const float* sh; int nloc; float* dst; int N;
    if (r0 < 5632) { wt = (const bf16_t*)(ws + OFF_WT_UP); sh = mod + 3 * 1024; nloc = r0; dst = SW; N = 5632; }
    else if (r0 < 7680) { wt = (const bf16_t*)(ws + OFF_WT_IN_ODD); sh = mod + 5 * 6144; nloc = r0 - 5632; dst = SW + 5 * 5632; N = 2048; }
    else { wt = (const bf16_t*)(ws + OFF_WT_UP + SZ_WT_UP); sh = mod + 5 * 6144 + 3 * 1024; nloc = r0 - 7680; dst = SW + 5 * 7680; N = 5632; }
    float shv[5][16];
#pragma unroll
    for (int cd = 0; cd < 5; ++cd)
#pragma unroll
        for (int q = 0; q < 4; ++q) { const f32x4 v = *(const f32x4*)(sh + (size_t)cd * 6144 + lane * 16 + 4 * q); shv[cd][4 * q] = v[0]; shv[cd][4 * q + 1] = v[1]; shv[cd][4 * q + 2] = v[2]; shv[cd][4 * q + 3] = v[3]; }
    for (int rr = 0; rr < 8; ++rr) {
        const bf16_t* rp = wt + (size_t)(nloc + rr) * 1024 + lane * 16;
        const u32x4 wa = *(const u32x4*)rp, wb = *(const u32x4*)(rp + 8);
        float wf[16]; { float t8[8]; unpack8(wa, t8);
#pragma unroll
            for (int j = 0; j < 8; ++j) wf[j] = t8[j];
            unpack8(wb, t8);
#pragma unroll
            for (int j = 0; j < 8; ++j) wf[8 + j] = t8[j]; }
        float acc5[5];
#pragma unroll
        for (int cd = 0; cd < 5; ++cd) { float a = 0.f;
#pragma unroll
            for (int j = 0; j < 16; ++j) a += shv[cd][j] * wf[j];
            acc5[cd] = wave_sum(a); }
        if (lane == 0) {
#pragma unroll
            for (int cd = 0; cd < 5; ++cd) dst[(size_t)cd * N + nloc + rr] = acc5[cd]; }
    }
}
DI void gs_tables(const Params& p, int t_lo, int t_hi, int gtid, int gsz) {
    unsigned char* ws = p.wsp();
    const float* mod = (const float*)(ws + OFF_MOD); float* GS = (float*)(ws + OFF_GS);
    for (int i = t_lo * 5120 + gtid; i < t_hi * 5120; i += gsz) { const int t = i / 5120, cd = (i / 1024) % 5, k = i & 1023;
        const float g = t == 0 ? p.norm_ffn_g[k] : (t == 1 ? p.norm_mix_g[1024 + k] : p.norm_ffn_g[1024 + k]);
        const float sc = mod[(size_t)((t == 0 ? 0 : 5) + cd) * 6144 + (t == 1 ? 1 : 4) * 1024 + k];
        GS[i] = g * (1.0f + sc); }
}

DI void bg_run(const Params& p, LAS unsigned char* lds, int q) {
    OPAQUE_IDS();
    (void)bid_o; (void)gdim_o;
    const int tid = tid_o;
    unsigned* ctr = (unsigned*)(p.wsp() + OFF_BAR) + 16 * q;
    volatile LAS int* slot = (volatile LAS int*)(lds + PTAB_OFF + 248);
    const int njobs = q == 0 ? 720 : (q == 1 ? 280 : (q == 2 ? 728 : 120));
    bool prepped = false;
    for (;;) {
        if (tid == 0) *slot = (int)__hip_atomic_fetch_add(ctr, 1u, __ATOMIC_RELAXED, __HIP_MEMORY_SCOPE_AGENT);
        __syncthreads();
        const int j = *slot;
        __syncthreads();
        if (j >= njobs) break;
        if (q == 0) {
            if (j < 592) { const int tile = j < 64 ? 144 + j : (j < 416 ? 400 + (j - 64) : 1104 + (j - 416)); transpose_tile(p, lds, tid, tile); }
            else { if (!prepped) { adaln_prep(p, lds, tid); prepped = true; } adaln_task(p, lds, tid, 64 + (j - 592)); }
        }
        else if (q == 1) {
            if (j < 192) { if (!prepped) { adaln_prep(p, lds, tid); prepped = true; } adaln_task(p, lds, tid, 192 + j); }
            else sw_chunk(p, (j - 192) * 8 + (tid >> 6), tid & 63);
        } else if (q == 2) {
            if (j < 720) { const int tile = j < 192 ? 208 + j : (j < 544 ? 752 + (j - 192) : 1280 + (j - 544)); transpose_tile(p, lds, tid, tile); }
            else wspatial_job(p, tid, j - 720);
        } else sw_chunk(p, 704 + j * 8 + (tid >> 6), tid & 63);
    }
}

DI void gs_l1_phase(const Params& p) { OPAQUE_IDS(); gs_tables(p, 1, 3, bid_o * NT + tid_o, gdim_o * NT); }
DI bool has_unit_n1024() { OPAQUE_IDS(); (void)tid_o; StaticOrder S; S.init(MROWS, 1024, gdim_o, bid_o); Unit u0; return S.next(0, u0); }

DI void phase0(const Params& p, LAS unsigned char* lds) {
    OPAQUE_IDS();
    const int tid = tid_o;
    unsigned char* ws = p.wsp();
    { float* rss = (float*)(ws + OFF_RSS); for (int i = bid_o * NT + tid; i < 4 * MROWS; i += gdim_o * NT) rss[i] = 0.f; }
    adaln_prep(p, lds, tid);
    for (int task = bid_o; task < 64; task += gdim_o) adaln_task(p, lds, tid, task);
    for (int j = gdim_o - 1 - bid_o; j < 144; j += gdim_o) transpose_tile(p, lds, tid, j);
    const int gtid = bid_o * NT + tid, gsz = gdim_o * NT;
    { bf16_t* kc = (bf16_t*)(ws + OFF_KC);
      for (int i = gtid; i < 32768; i += gsz) { const int r = i & 31, h = (i >> 5) & 1, sst = (i >> 6) & 3, chunk = (i >> 8) & 15, hk = (i >> 12) & 1, b = i >> 13;
          const float* sp = p.cache_k + ((size_t)(b * 512 + chunk * 32 + r) * 2 + hk) * 64 + sst * 16 + h * 8;
          const f32x4 a = *(const f32x4*)sp, bb = *(const f32x4*)(sp + 4);
          u32x4 w; w.x = pk2(a[0], a[1]); w.y = pk2(a[2], a[3]); w.z = pk2(bb[0], bb[1]); w.w = pk2(bb[2], bb[3]); *(u32x4*)(kc + (size_t)i * 8) = w; } }
    { bf16_t* vct = (bf16_t*)(ws + OFF_VCT);
      for (int i = gtid; i < 32768; i += gsz) { const int lr = i & 31, hh = (i >> 5) & 1, ks = (i >> 6) & 1, db = (i >> 7) & 1, chunk = (i >> 8) & 15, hk = (i >> 12) & 1, b = i >> 13; float f[8];
#pragma unroll
          for (int j = 0; j < 8; ++j) { const int key = chunk * 32 + 16 * ks + 8 * (j >> 2) + 4 * hh + (j & 3); f[j] = p.cache_v[((size_t)(b * 512 + key) * 2 + hk) * 64 + 32 * db + lr]; }
          *(u32x4*)(vct + (size_t)i * 8) = pack8(f); } }
    { f32x2* rope = (f32x2*)(ws + OFF_ROPE);
      for (int i = gtid; i < 1024; i += gsz) { const int pos = i >> 4, f = i & 15; const float inv = powf(10000.0f, -(float)f / 16.0f); const float ang = (float)pos * inv;
          float sv, cv; sincosf(ang, &sv, &cv); rope[i] = (f32x2){cv, sv}; } }
}

DI void modulate_phase(const float* xp, const float* xs, const float* g, const float* mod_l  , int shift_i, bf16_t* H) {
    OPAQUE_IDS();
    const int tid = tid_o, wid = tid >> 6, lane = tid & 63;
    const int W = gdim_o * 8;
    for (int row = bid_o * 8 + wid; row < MROWS; row += W) {
        const float* xr = row < MP ? xp + (size_t)row * DM : xs + (size_t)(row - MP) * DM;
        const int cond = row < MP ? 0 : 1 + ((row - MP) >> 11);
        f32x4 v[4]; float ss = 0.f;
#pragma unroll
        for (int i = 0; i < 4; ++i) { v[i] = __builtin_nontemporal_load((const f32x4*)(xr + 512 * (i >> 1) + 8 * lane + 4 * (i & 1))); ss += (v[i][0] * v[i][0] + v[i][1] * v[i][1]) + (v[i][2] * v[i][2] + v[i][3] * v[i][3]); }
        ss = wave_sum(ss);
        const float rstd = rsqrtf(ss * (1.0f / 1024.0f) + 1e-6f);
        const float* sh = mod_l + (size_t)cond * 6144 + shift_i * 1024; const float* sc = sh + 1024;
#pragma unroll
        for (int i2 = 0; i2 < 2; ++i2) { const int col = 512 * i2 + 8 * lane; f32x4 h[2];
#pragma unroll
            for (int q = 0; q < 2; ++q) { const f32x4 gg = *(const f32x4*)(g + col + 4 * q), s1 = *(const f32x4*)(sc + col + 4 * q), s0 = *(const f32x4*)(sh + col + 4 * q);
                h[q] = v[2 * i2 + q] * rstd * gg * (s1 + 1.0f) + s0; }
            u32x4 w; w.x = pk2(h[0][0], h[0][1]); w.y = pk2(h[0][2], h[0][3]); w.z = pk2(h[1][0], h[1][1]); w.w = pk2(h[1][2], h[1][3]); *(u32x4*)(H + (size_t)row * DM + col) = w; }
    }
}

DI void tables_phase(const Params& p) {
    OPAQUE_IDS();
    gs_tables(p, 0, 1, bid_o * NT + tid_o, gdim_o * NT);
}

#define MFMA32(a, b, c) __builtin_amdgcn_mfma_f32_32x32x16_bf16((a), (b), (c), 0, 0, 0)
DI void attn_phase(const Params& p) {
    OPAQUE_IDS();
    unsigned char* ws = p.wsp();
    const bf16_t* Q = (const bf16_t*)(ws + OFF_Q); const bf16_t* Kb = (const bf16_t*)(ws + OFF_KB); const bf16_t* Vt = (const bf16_t*)(ws + OFF_VT);
    const bf16_t* BCH = (const bf16_t*)(ws + OFF_BCH); const bf16_t* Kc = (const bf16_t*)(ws + OFF_KC); const bf16_t* Vct = (const bf16_t*)(ws + OFF_VCT);
    bf16_t* MIX = (bf16_t*)(ws + OFF_MIX);
    const int tid = tid_o, wid = tid >> 6, lane = tid & 63;
    const int cW = gdim_o * 8 > 1024 ? gdim_o * 8 - 1024 : gdim_o * 8, cw0 = gdim_o * 8 > 1024 ? bid_o * 8 + wid - 1024 : bid_o * 8 + wid;
    for (int idx = cw0 >= 0 ? cw0 * 64 + lane : 1536 * 64; idx < 1536 * 64; idx += cW * 64) {
        const int rg = idx >> 6, cg8 = idx & 63; const int row0 = rg * 8, j0 = cg8 * 8;
        const int smask = row0 < MP ? 255 : 2047;
        float w0[8], w1[8], w2[8];
        { const f32x4 a = *(const f32x4*)(p.short_conv_w + j0), b = *(const f32x4*)(p.short_conv_w + j0 + 4); w0[0] = a[0]; w0[1] = a[1]; w0[2] = a[2]; w0[3] = a[3]; w0[4] = b[0]; w0[5] = b[1]; w0[6] = b[2]; w0[7] = b[3]; }
        { const f32x4 a = *(const f32x4*)(p.short_conv_w + 512 + j0), b = *(const f32x4*)(p.short_conv_w + 512 + j0 + 4); w1[0] = a[0]; w1[1] = a[1]; w1[2] = a[2]; w1[3] = a[3]; w1[4] = b[0]; w1[5] = b[1]; w1[6] = b[2]; w1[7] = b[3]; }
        { const f32x4 a = *(const f32x4*)(p.short_conv_w + 1024 + j0), b = *(const f32x4*)(p.short_conv_w + 1024 + j0 + 4); w2[0] = a[0]; w2[1] = a[1]; w2[2] = a[2]; w2[3] = a[3]; w2[4] = b[0]; w2[5] = b[1]; w2[6] = b[2]; w2[7] = b[3]; }
        u32x4 cw[10], hw[10], bw[8];
        const u32x4 z4 = {0u, 0u, 0u, 0u};
#pragma unroll
        for (int i = 0; i < 10; ++i) { const int r = row0 - 1 + i;
            const bool ok = (i == 0) ? ((row0 & smask) != 0) : (i == 9 ? (((row0 + 8) & smask) != 0) : true);
            if (ok) { cw[i] = __builtin_nontemporal_load((const u32x4*)(BCH + (size_t)r * 1536 + 512 + j0)); hw[i] = __builtin_nontemporal_load((const u32x4*)(BCH + (size_t)r * 1536 + 1024 + j0)); } else { cw[i] = z4; hw[i] = z4; } }
#pragma unroll
        for (int i = 0; i < 8; ++i) bw[i] = __builtin_nontemporal_load((const u32x4*)(BCH + (size_t)(row0 + i) * 1536 + j0));
        float pv[8], cv[8], nv[8];
        { float a[8], b[8]; unpack8(cw[0], a); unpack8(hw[0], b);
#pragma unroll
          for (int j = 0; j < 8; ++j) pv[j] = a[j] * b[j];
          unpack8(cw[1], a); unpack8(hw[1], b);
#pragma unroll
          for (int j = 0; j < 8; ++j) cv[j] = a[j] * b[j]; }
#pragma unroll
        for (int i = 0; i < 8; ++i) {
            float a[8], b[8], o[8]; unpack8(cw[i + 2], a); unpack8(hw[i + 2], b);
#pragma unroll
            for (int j = 0; j < 8; ++j) nv[j] = a[j] * b[j];
            unpack8(bw[i], a);
#pragma unroll
            for (int j = 0; j < 8; ++j) { o[j] = a[j] * (w0[j] * pv[j] + w1[j] * cv[j] + w2[j] * nv[j]); pv[j] = cv[j]; cv[j] = nv[j]; }
            st16(MIX + (size_t)(row0 + i) * DM + 512 + j0, pack8(o));
        }
    }
    const int h = lane >> 5, r = lane & 31;
    const int W = gdim_o * 8, gw = bid_o * 8 + wid;
    const float C1 = 0.125f * 1.4426950408889634f;
    for (int unit = gw; unit < 3072; unit += W) {
        const bool samp = unit < 2048;
        int b, head, q0, row0, nband, clo; const bf16_t* kbase; const bf16_t* vbase;
        if (samp) { b = unit >> 9; head = (unit >> 6) & 7; q0 = (unit & 63) * 32; row0 = MP + b * 2048 + q0; const int hk = head >> 2;
            kbase = Kb + 524288 + (size_t)((b * 2 + hk) * 64) * 2048; vbase = Vt + 524288 + (size_t)((b * 2 + hk) * 64) * 2048;
            clo = q0 >= 128 ? 0 : (128 - q0) >> 5; int chi = (2144 - q0) >> 5; if (chi > 8) chi = 8; nband = chi - clo + 1; }
        else { const int u2 = unit - 2048; b = u2 >> 6; head = (u2 >> 3) & 7; q0 = (u2 & 7) * 32; row0 = b * 256 + q0; const int hk = head >> 2;
            kbase = Kb + (size_t)((b * 2 + hk) * 8) * 2048; vbase = Vt + (size_t)((b * 2 + hk) * 8) * 2048; clo = 0; nband = 8; }
        const int hk = head >> 2;
        const bf16_t* kcb = Kc + (size_t)((b * 2 + hk) * 16) * 2048; const bf16_t* vcb = Vct + (size_t)((b * 2 + hk) * 16) * 2048;
        const int nch = samp ? nband + 16 : nband;
        bf16x8 qf[4];
#pragma unroll
        for (int s = 0; s < 4; ++s) qf[s] = *(const bf16x8*)(Q + (size_t)(row0 + r) * 512 + head * 64 + 16 * s + 8 * h);
        float mrun = p.sink_logit[head] * 1.4426950408889634f, lrun = 1.0f;
        f32x16 O0, O1;
#pragma unroll
        for (int i = 0; i < 16; ++i) { O0[i] = 0.f; O1[i] = 0.f; }
        const bf16_t* kp; const bf16_t* vp; int mk;
#define CHUNK_PTRS(it) do { if ((it) < nband) { const int cc_ = clo + (it); const int ci_ = samp ? ((q0 - 128) >> 5) + cc_ : cc_; kp = kbase + (size_t)ci_ * 2048; vp = vbase + (size_t)ci_ * 2048; \
            mk = samp ? (cc_ == 0 ? 1 : (cc_ == 8 ? 2 : 0)) : 0; } else { const int ci_ = (it) - nband; kp = kcb + (size_t)ci_ * 2048; vp = vcb + (size_t)ci_ * 2048; mk = 0; } } while (0)
        bf16x8 kn[4], vn[4];
        CHUNK_PTRS(0);
#pragma unroll
        for (int s = 0; s < 4; ++s) { kn[s] = *(const bf16x8*)(kp + (s * 64 + lane) * 8); vn[s] = *(const bf16x8*)(vp + (s * 64 + lane) * 8); }
        for (int it = 0; it < nch; ++it) {
            CHUNK_PTRS(it);
            const int mkc = mk;
            bf16x8 kf[4], vf[4];
#pragma unroll
            for (int s = 0; s < 4; ++s) { kf[s] = kn[s]; vf[s] = vn[s]; }
            if (it + 1 < nch) { CHUNK_PTRS(it + 1);
#pragma unroll
                for (int s = 0; s < 4; ++s) { kn[s] = *(const bf16x8*)(kp + (s * 64 + lane) * 8); vn[s] = *(const bf16x8*)(vp + (s * 64 + lane) * 8); } }
            f32x16 sa;
#pragma unroll
            for (int i = 0; i < 16; ++i) sa[i] = 0.f;
#pragma unroll
            for (int s = 0; s < 4; ++s) sa = MFMA32(kf[s], qf[s], sa);
            float tv[16]; float cm = -1e30f;
            if (mkc != 0) {
#pragma unroll
                for (int i = 0; i < 16; ++i) { const int koff = (i & 3) + 8 * (i >> 2) + 4 * h;
                    const bool ok = (mkc == 1) ? (koff >= r) : (koff <= r);
                    sa[i] = ok ? sa[i] : -1e30f; }
            }
#pragma unroll
            for (int i = 0; i < 16; ++i) cm = fmaxf(cm, sa[i]);
            cm = xmax32(cm) * C1;
            const float mnew = fmaxf(mrun, cm);
            const float alpha = __builtin_amdgcn_exp2f(mrun - mnew);
            float ps = 0.f;
#pragma unroll
            for (int i = 0; i < 16; ++i) { tv[i] = __builtin_amdgcn_exp2f(__builtin_fmaf(sa[i], C1, -mnew)); ps += tv[i]; }
            ps = xsum32(ps);
            lrun = lrun * alpha + ps; mrun = mnew;
            if (__builtin_amdgcn_ballot_w64(alpha != 1.0f) != 0ull) {
#pragma unroll
                for (int i = 0; i < 16; ++i) { O0[i] *= alpha; O1[i] *= alpha; } }
#pragma unroll
            for (int ks = 0; ks < 2; ++ks) { u32x4 w; w.x = pk2(tv[8 * ks + 0], tv[8 * ks + 1]); w.y = pk2(tv[8 * ks + 2], tv[8 * ks + 3]); w.z = pk2(tv[8 * ks + 4], tv[8 * ks + 5]); w.w = pk2(tv[8 * ks + 6], tv[8 * ks + 7]);
                const bf16x8 pb = __builtin_bit_cast(bf16x8, w);
                O0 = MFMA32(vf[ks], pb, O0); O1 = MFMA32(vf[2 + ks], pb, O1); }
        }
#undef CHUNK_PTRS
        const float inv = 1.0f / lrun;
        bf16_t* op = MIX + (size_t)(row0 + r) * DM + head * 64 + 4 * h;
#pragma unroll
        for (int j = 0; j < 4; ++j) { u32x2 w; w.x = pk2(O0[4 * j] * inv, O0[4 * j + 1] * inv); w.y = pk2(O0[4 * j + 2] * inv, O0[4 * j + 3] * inv); st8(op + 8 * j, w);
            u32x2 w2; w2.x = pk2(O1[4 * j] * inv, O1[4 * j + 1] * inv); w2.y = pk2(O1[4 * j + 2] * inv, O1[4 * j + 3] * inv); st8(op + 32 + 8 * j, w2); }
    }
}

DI void spatial_phase(const Params& p, LAS unsigned char* lds) {
    OPAQUE_IDS();
    unsigned char* ws = p.wsp();
    const bf16_t* UG = (const bf16_t*)(ws + OFF_UG); const bf16_t* V1 = (const bf16_t*)(ws + OFF_V1); const bf16_t* WS = (const bf16_t*)(ws + OFF_WSP);
    const float* rss = (const float*)(ws + OFF_RSS); bf16_t* MIX = (bf16_t*)(ws + OFF_MIX);
    LAS bf16_t* VT = (LAS bf16_t*)lds;
    LAS float* RS = (LAS float*)(lds + 128 * 136 * 2);
    const int tid = tid_o, wid = tid >> 6, lane = tid & 63, h = lane >> 5, r = lane & 31;
    const int tb = wid >> 1, chh = wid & 1;
    for (int task = bid_o; task < 768; task += gdim_o) {
        const int chunk = task >> 3, g = task & 7; const int rowb = chunk * 128;
#pragma unroll
        for (int i = 0; i < 4; ++i) { const int e = tid + NT * i; const int s = e >> 4, c8 = e & 15;
            const u32x4 w = __builtin_nontemporal_load((const u32x4*)(V1 + (size_t)(rowb + s) * 1024 + g * 128 + c8 * 8)); *(LAS u32x4*)(VT + s * 136 + c8 * 8) = w; }
        if (tid < 128) RS[tid] = rsqrtf(rss[rowb + tid] * (1.0f / 1024.0f) + 1e-6f);
        const int t0 = tb * 32, c0 = chh * 64;
        u32x4 wpre[8];
#pragma unroll
        for (int kk = 0; kk < 8; ++kk) wpre[kk] = *(const u32x4*)(WS + (size_t)(g * 128 + t0 + r) * 128 + 16 * kk + 8 * h);
        bf16_t upre[2][16];
#pragma unroll
        for (int i = 0; i < 16; ++i) { const int t = t0 + (i & 3) + 8 * (i >> 2) + 4 * h; const size_t o = (size_t)(rowb + t) * 1024 + g * 128 + c0 + r; upre[0][i] = UG[o]; upre[1][i] = UG[o + 32]; }
        __syncthreads();
        f32x16 a0, a1;
#pragma unroll
        for (int i = 0; i < 16; ++i) { a0[i] = 0.f; a1[i] = 0.f; }
#pragma unroll
        for (int kk = 0; kk < 8; ++kk) {
            const int s0 = 16 * kk + 8 * h;
            const u32x4 wa = wpre[kk];
            float fa[8]; unpack8(wa, fa);
            const f32x4 r0 = *(const LAS f32x4*)(RS + s0), r1 = *(const LAS f32x4*)(RS + s0 + 4);
            fa[0] *= r0[0]; fa[1] *= r0[1]; fa[2] *= r0[2]; fa[3] *= r0[3]; fa[4] *= r1[0]; fa[5] *= r1[1]; fa[6] *= r1[2]; fa[7] *= r1[3];
            const bf16x8 af = __builtin_bit_cast(bf16x8, pack8(fa));
            bf16x8 b0, b1;
#pragma unroll
            for (int j = 0; j < 8; ++j) { b0[j] = (short)VT[(s0 + j) * 136 + c0 + r]; b1[j] = (short)VT[(s0 + j) * 136 + c0 + 32 + r]; }
            a0 = MFMA32(af, b0, a0); a1 = MFMA32(af, b1, a1);
        }
        const float vg0 = p.gmlp_norm_g[g * 128 + c0 + r], vg1 = p.gmlp_norm_g[g * 128 + c0 + 32 + r];
#pragma unroll
        for (int i = 0; i < 16; ++i) { const int t = t0 + (i & 3) + 8 * (i >> 2) + 4 * h; const float bs = p.b_spatial[g * 128 + t];
            const size_t o = (size_t)(rowb + t) * 1024 + g * 128 + c0 + r;
            const float u0 = bflo((unsigned)upre[0][i]), u1 = bflo((unsigned)upre[1][i]);
            MIX[o] = f2bf(u0 * (a0[i] * vg0 + bs)); MIX[o + 32] = f2bf(u1 * (a1[i] * vg1 + bs)); }
        __syncthreads();
    }
}

DI void edge_fixup(const bf16_t* EDGE, bf16_t* ACT, const float* cw  , int pm) {
    OPAQUE_IDS();
    (void)bid_o; (void)gdim_o;
    for (int idx = tid_o; idx < 2 * 352; idx += NT) {
        const int half = idx / 352, cgp = idx - half * 352, j0 = cgp * 8;
        f32x4 a[3][2], b[3][2];
#pragma unroll
        for (int tp = 0; tp < 3; ++tp)
#pragma unroll
            for (int hh = 0; hh < 2; ++hh) { a[tp][hh] = *(const f32x4*)(cw + tp * 5632 + j0 + 4 * hh); b[tp][hh] = *(const f32x4*)(cw + tp * 5632 + 2816 + j0 + 4 * hh); }
        u32x4 gw[4][3], vw[4][3];
        const u32x4 z4 = {0u, 0u, 0u, 0u};
#pragma unroll
        for (int q = 0; q < 4; ++q) {
            const int er = half * 4 + q;
            const int band = pm * 4 + (er >> 1), last = er & 1, row = band * 64 + (last ? 63 : 0);
            const int smask = row < MP ? 255 : 2047;
            const bf16_t *pp, *pc, *pn; bool okp = true, okn = true;
            if (!last) { pc = EDGE + (size_t)(band * 4 + 0) * 5632; pn = EDGE + (size_t)(band * 4 + 1) * 5632; okp = (row & smask) != 0; pp = EDGE + (size_t)((okp ? band - 1 : band) * 4 + 3) * 5632; }
            else { pp = EDGE + (size_t)(band * 4 + 2) * 5632; pc = EDGE + (size_t)(band * 4 + 3) * 5632; okn = ((row + 1) & smask) != 0; pn = EDGE + (size_t)((okn ? band + 1 : band) * 4 + 0) * 5632; }
            gw[q][0] = okp ? *(const u32x4*)(pp + j0) : z4; vw[q][0] = okp ? *(const u32x4*)(pp + 2816 + j0) : z4;
            gw[q][1] = *(const u32x4*)(pc + j0); vw[q][1] = *(const u32x4*)(pc + 2816 + j0);
            gw[q][2] = okn ? *(const u32x4*)(pn + j0) : z4; vw[q][2] = okn ? *(const u32x4*)(pn + 2816 + j0) : z4;
        }
#pragma unroll
        for (int q = 0; q < 4; ++q) {
            const int er = half * 4 + q;
            const int row = (pm * 4 + (er >> 1)) * 64 + ((er & 1) ? 63 : 0);
            float gp[8], gc[8], gn[8], vp[8], vc[8], vn[8], o[8];
            unpack8(gw[q][0], gp); unpack8(gw[q][1], gc); unpack8(gw[q][2], gn); unpack8(vw[q][0], vp); unpack8(vw[q][1], vc); unpack8(vw[q][2], vn);
#pragma unroll
            for (int hh = 0; hh < 2; ++hh)
#pragma unroll
                for (int e = 0; e < 4; ++e) { const int j = 4 * hh + e;
                    const float g = a[0][hh][e] * gp[j] + a[1][hh][e] * gc[j] + a[2][hh][e] * gn[j]; const float v = b[0][hh][e] * vp[j] + b[1][hh][e] * vc[j] + b[2][hh][e] * vn[j];
                    o[j] = silu_f(g) * v; }
            *(u32x4*)(ACT + (size_t)row * 2816 + j0) = pack8(o);
        }
    }
    asm volatile("s_waitcnt vmcnt(0)" ::: "memory");
    __syncthreads();
}

#define XB_TMO      128
#define XB_XCNT(j)  (256  + 64 * (j))
#define XB_XSUB(j)  (1280 + 64 * (j))
#define XB_XGEN(j)  (2304 + 64 * (j))
#define XB_TOP      3328
#define XB_TOPGEN   3392
#define XCD_BAR_WORDS 3456
#define XB_SPIN_CAP (1u << 20)
DI unsigned xb_ld(unsigned* p)              { return __hip_atomic_load(p, __ATOMIC_RELAXED, __HIP_MEMORY_SCOPE_AGENT); }
DI unsigned xb_add(unsigned* p, unsigned v) { return __hip_atomic_fetch_add(p, v, __ATOMIC_RELAXED, __HIP_MEMORY_SCOPE_AGENT); }
DI unsigned xb_xcc_id() { return (unsigned)__builtin_amdgcn_s_getreg((3 << 11) | 20) & 0xFu; }
#define XB_SPIN(cond, bar) do { unsigned _sp = 0; while (cond) { __builtin_amdgcn_s_sleep(1); \
    if ((++_sp & 255u) == 0u) { if (xb_ld(&(bar)[XB_TMO])) break; if (_sp > XB_SPIN_CAP) { atomicAdd(&(bar)[XB_TMO], 1u); break; } } } } while (0)
DI void xcd_barrier_complete(unsigned* bar, unsigned x, unsigned G, unsigned& nloc, unsigned& nx) {
    unsigned sum, cnt, mine, sp = 0u;
    for (;;) {
        sum = 0u; cnt = 0u; mine = 0u;
#pragma unroll
        for (unsigned j = 0; j < 16; ++j) { const unsigned c = xb_ld(&bar[XB_XCNT(j)]); sum += c; cnt += (c > 0u) ? 1u : 0u; mine = (j == x) ? c : mine; }
        if (sum == G) break;
        __builtin_amdgcn_s_sleep(1);
        if ((++sp & 255u) == 0u) { if (xb_ld(&bar[XB_TMO])) break; if (sp > XB_SPIN_CAP) { atomicAdd(&bar[XB_TMO], 1u); break; } }
    }
    nloc = mine > 0u ? mine : 1u; nx = cnt > 0u ? cnt : 1u;
}
DI void xcd_barrier(unsigned* bar, volatile LAS unsigned* st) {
    asm volatile("s_waitcnt vmcnt(0)" ::: "memory");
    __syncthreads();
    if (threadIdx.x == 0) {
        const unsigned x = xb_xcc_id();
        __builtin_amdgcn_s_waitcnt(0);
        unsigned nloc = st[0], nx = st[1];
        if (nloc == 0u) { xcd_barrier_complete(bar, x, gridDim.x, nloc, nx); st[0] = nloc; st[1] = nx; }
        const unsigned old = xb_add(&bar[XB_XSUB(x)], 1u);
        const unsigned gen = old / nloc;
        if (old + 1u == (gen + 1u) * nloc) {
            __builtin_amdgcn_fence(__ATOMIC_RELEASE, "agent");
            asm volatile("s_waitcnt vmcnt(0)" ::: "memory");
            const unsigned og = xb_add(&bar[XB_TOP], 1u);
            const unsigned tg = og / nx;
            if (og + 1u == (tg + 1u) * nx) xb_add(&bar[XB_TOPGEN], 1u);
            else XB_SPIN(xb_ld(&bar[XB_TOPGEN]) == tg, bar);
            __builtin_amdgcn_fence(__ATOMIC_ACQUIRE, "agent");
            xb_add(&bar[XB_XGEN(x)], 1u);
            asm volatile("s_waitcnt vmcnt(0)" ::: "memory");
        } else {
            XB_SPIN(xb_ld(&bar[XB_XGEN(x)]) == gen, bar);
            __builtin_amdgcn_fence(__ATOMIC_ACQUIRE, "agent");
            asm volatile("s_waitcnt vmcnt(0)" ::: "memory");
        }
    }
    __syncthreads();
}

__global__ void __launch_bounds__(NT, 2) mega(KArgs ka) {
    extern __shared__ __attribute__((aligned(16))) unsigned char lds_raw[];
    LAS unsigned char* lds = (LAS unsigned char*)lds_raw;
    cg::grid_group grid = cg::this_grid();
    Params p; p.tab = (LAS unsigned long long*)(lds + PTAB_OFF);
    volatile LAS unsigned* bst = (volatile LAS unsigned*)(lds + PTAB_OFF + 240);
    if (threadIdx.x == 0) {
#pragma unroll
        for (int i = 0; i < 24; ++i) p.tab[i] = (unsigned long long)ka.in[i];
        p.tab[24] = (unsigned long long)ka.out; p.tab[25] = (unsigned long long)ka.ws;
        bst[0] = 0u; bst[1] = 0u;
        (void)xb_add(&((unsigned*)(ka.ws + OFF_BAR))[XB_XCNT(xb_xcc_id())], 1u);
    }
    __syncthreads();
    const int lo = ka.ph_lo, hi = ka.ph_hi;
#define IN(k) (lo <= (k) && (k) < hi)
    if (ka.ph_hi > 1000) grid.sync();
#define SEAM(k) do { if (IN(k) && IN((k) + 1)) xcd_barrier((unsigned*)(p.wsp() + OFF_BAR), bst); } while (0)

    if (IN(0)) for (int rep = 0; rep < REPS(0); ++rep) phase0(p, lds);
    SEAM(0);
    for (int layer = 0; layer < 2; ++layer) {
        if (layer == 0) {
            if (IN(1)) { unsigned char* ws = p.wsp();
                for (int rep = 0; rep < REPS(1); ++rep) modulate_phase(p.x_prompt, p.x_sample, p.norm_mix_g, (const float*)(ws + OFF_MOD), 0, (bf16_t*)(ws + OFF_H));
                }
            SEAM(1);
            if (IN(2)) { unsigned char* ws = p.wsp(); float* xo = p.outp();
                Gemm g{(const bf16_t*)(ws + OFF_H), (const bf16_t*)(ws + OFF_WT_IN_EVEN), MROWS, 2304, 1024};
                EpiInEven E{(bf16_t*)(ws + OFF_Q), (bf16_t*)(ws + OFF_KB), (bf16_t*)(ws + OFF_VT), (bf16_t*)(ws + OFF_BCH),
                            xo + (size_t)MROWS * DM, xo + (size_t)MROWS * DM + 524288, p.q_norm_g, p.k_norm_g, (const f32x2*)(ws + OFF_ROPE)};
                for (int rep = 0; rep < REPS(2); ++rep) gemm_phase(lds, g, E);
                bg_run(p, lds, 0);
            }
            SEAM(2);
            if (IN(3)) { tables_phase(p);
                for (int rep = 0; rep < REPS(3); ++rep) attn_phase(p); }
            SEAM(3);
        } else {
            if (IN(7)) { unsigned char* ws = p.wsp();
                Gemm g{(const bf16_t*)(ws + OFF_H), (const bf16_t*)(ws + OFF_WT_IN_ODD), MROWS, 2048, 1024};
                EpiInOdd E{(bf16_t*)(ws + OFF_UG), (bf16_t*)(ws + OFF_V1), (float*)(ws + OFF_RSS), (const float*)(ws + OFF_RSS) + 2 * MROWS, (const float*)(ws + OFF_SW) + 5 * 5632};
                gemm_phase(lds, g, E);
            }
            SEAM(7);
            if (IN(8)) for (int rep = 0; rep < REPS(11); ++rep) spatial_phase(p, lds);
            SEAM(8);
        }
        const int pb = layer == 0 ? 4 : 9;
        if (IN(pb)) { unsigned char* ws = p.wsp(); float* xo = p.outp();
            Gemm g{(const bf16_t*)(ws + OFF_MIX), (const bf16_t*)(ws + (layer == 0 ? OFF_WT_OUT_EVEN : OFF_WT_OUT_ODD)), MROWS, 1024, 1024};
            EpiResid E{p.x_prompt, p.x_sample, layer == 0 ? (const bf16_t*)nullptr : (const bf16_t*)(ws + OFF_XB), xo, (bf16_t*)(ws + OFF_XB),
                       (const float*)(ws + OFF_MOD) + (size_t)layer * 5 * 6144 + 2 * 1024,
                       (bf16_t*)(ws + OFF_H), (const float*)(ws + OFF_GS) + (layer == 0 ? 0 : 2) * 5120, (float*)(ws + OFF_RSS) + (layer == 0 ? 1 : 3) * MROWS};
            gemm_phase(lds, g, E);
            if (layer == 0) bg_run(p, lds, 1);
        }
        SEAM(pb);
        if (IN(pb + 1)) { unsigned char* ws = p.wsp();
            if (layer == 0) gs_l1_phase(p);
            Gemm g{(const bf16_t*)(ws + OFF_H), (const bf16_t*)(ws + OFF_WT_UP + (size_t)layer * SZ_WT_UP), MROWS, 5632, 1024};
            EpiUpConv E{(bf16_t*)(ws + OFF_ACT), (bf16_t*)(ws + OFF_EDGE), p.ffn_conv_w + (size_t)layer * 3 * 5632,
                        (const float*)(ws + OFF_RSS) + (layer == 0 ? 1 : 3) * MROWS, (const float*)(ws + OFF_SW) + (layer == 0 ? 0 : 5 * 7680)};
            gemm_phase(lds, g, E);
            if (layer == 0) bg_run(p, lds, 2);
        }
        SEAM(pb + 1);
        if (IN(pb + 2)) { unsigned char* ws = p.wsp(); float* xo = p.outp();
            { StaticOrder S; S.init(MROWS, 1024, (int)gridDim.x, (int)blockIdx.x); Unit u0;
              for (int i = 0; S.next(i, u0); ++i) edge_fixup((const bf16_t*)(ws + OFF_EDGE), (bf16_t*)(ws + OFF_ACT), p.ffn_conv_w + (size_t)layer * 3 * 5632, u0.pm); }
            Gemm g{(const bf16_t*)(ws + OFF_ACT), (const bf16_t*)(ws + OFF_WT_DOWN + (size_t)layer * SZ_WT_DOWN), MROWS, 1024, 2816};
            EpiResid E{xo, xo, (const bf16_t*)(ws + OFF_XB), xo, layer == 0 ? (bf16_t*)(ws + OFF_XB) : (bf16_t*)nullptr,
                       (const float*)(ws + OFF_MOD) + (size_t)layer * 5 * 6144 + 5 * 1024,
                       layer == 0 ? (bf16_t*)(ws + OFF_H) : (bf16_t*)nullptr, (const float*)(ws + OFF_GS) + 5120, (float*)(ws + OFF_RSS) + 2 * MROWS};
            gemm_phase(lds, g, E);
            if (layer == 0) bg_run(p, lds, 3);
        }
        SEAM(pb + 2);
    }
#undef IN
#undef SEAM
}

constexpr int LDS_TOTAL = LDS_BYTES + 256;
extern "C" void kernel_launch(void* const* d_in, const int* in_sizes, int n_in, void* d_out, int out_size, void* d_ws, size_t ws_size, hipStream_t stream) {
    static int grid = 0;
    if (grid == 0) {
        int dev = 0, cus = 0, per_cu = 0;
        (void)hipGetDevice(&dev);
        (void)hipDeviceGetAttribute(&cus, hipDeviceAttributeMultiprocessorCount, dev);
        if (hipFuncSetAttribute((const void*)mega, hipFuncAttributeMaxDynamicSharedMemorySize, LDS_TOTAL) != hipSuccess) { fprintf(stderr, "hipFuncSetAttribute failed\n"); grid = -1; return; }
        if (hipOccupancyMaxActiveBlocksPerMultiprocessor(&per_cu, (const void*)mega, NT, LDS_TOTAL) != hipSuccess || per_cu < 1) { fprintf(stderr, "occupancy query failed (%d)\n", per_cu); (void)hipGetLastError(); per_cu = 1; }
        if (per_cu > 1) per_cu = 1;
        grid = cus * per_cu;
    }
    if (grid < 0) return;
    KArgs ka{};
    for (int i = 0; i < 24; ++i) ka.in[i] = (const float*)d_in[i];
    ka.out = (float*)d_out; ka.ws = (unsigned char*)d_ws;
    if (hipMemsetAsync((unsigned char*)d_ws + OFF_BAR, 0, BAR_BYTES, stream) != hipSuccess) { fprintf(stderr, "memset failed\n"); return; }
#if COOP
    ka.ph_lo = 0; ka.ph_hi = 12;
    void* args[] = {&ka};
    hipError_t e = hipLaunchCooperativeKernel((const void*)mega, dim3(grid), dim3(NT), args, LDS_TOTAL, stream);
    if (e != hipSuccess) fprintf(stderr, "cooperative launch failed: %s (grid %d)\n", hipGetErrorString(e), grid);
#else
    for (int ph = 0; ph < 12; ++ph) { ka.ph_lo = ph; ka.ph_hi = ph + 1; hipLaunchKernelGGL(mega, dim3(grid), dim3(NT), LDS_TOTAL, stream, ka); }
#endif
}
```

```cpp
#include <hip/hip_runtime.h>
#include <hip/hip_cooperative_groups.h>
#include <cstdio>
namespace cg = cooperative_groups;

#ifndef COOP
#define COOP 1
#endif
#ifndef REPMASK
#define REPMASK 0
#endif
#define REPS(k) (1 + ((REPMASK >> (k)) & 1))

#define LAS __attribute__((address_space(3)))
#define DI __device__ __forceinline__
typedef unsigned short bf16_t;
typedef short bf16x8 __attribute__((ext_vector_type(8)));
typedef float f32x4 __attribute__((ext_vector_type(4)));
typedef float f32x2 __attribute__((ext_vector_type(2)));
typedef float f32x16 __attribute__((ext_vector_type(16)));
typedef unsigned u32x4 __attribute__((ext_vector_type(4)));
typedef unsigned u32x2 __attribute__((ext_vector_type(2)));
typedef __bf16 bf2_t __attribute__((ext_vector_type(2)));

DI unsigned pk2(float a, float b) { f32x2 v = {a, b}; bf2_t r = __builtin_convertvector(v, bf2_t); return __builtin_bit_cast(unsigned, r); }
DI float bflo(unsigned w) { return __uint_as_float(w << 16); }
DI float bfhi(unsigned w) { return __uint_as_float(w & 0xffff0000u); }
DI bf16_t f2bf(float a) { return (bf16_t)(pk2(a, 0.f) & 0xffffu); }
DI void unpack8(const u32x4 w, float (&f)[8]) {
    f[0] = bflo(w.x); f[1] = bfhi(w.x); f[2] = bflo(w.y); f[3] = bfhi(w.y); f[4] = bflo(w.z); f[5] = bfhi(w.z); f[6] = bflo(w.w); f[7] = bfhi(w.w);
}
DI u32x4 pack8(const float (&f)[8]) { u32x4 w; w.x = pk2(f[0], f[1]); w.y = pk2(f[2], f[3]); w.z = pk2(f[4], f[5]); w.w = pk2(f[6], f[7]); return w; }

DI float xsum32(float x) { auto r = __builtin_amdgcn_permlane32_swap(__float_as_uint(x), __float_as_uint(x), false, false); return __uint_as_float(r[0]) + __uint_as_float(r[1]); }
DI float xmax32(float x) { auto r = __builtin_amdgcn_permlane32_swap(__float_as_uint(x), __float_as_uint(x), false, false); return fmaxf(__uint_as_float(r[0]), __uint_as_float(r[1])); }
DI float xsum16(float x) { auto r = __builtin_amdgcn_permlane16_swap(__float_as_uint(x), __float_as_uint(x), false, false); return __uint_as_float(r[0]) + __uint_as_float(r[1]); }
DI float wave_sum(float x) {
    x += __int_as_float(__builtin_amdgcn_update_dpp(0, __float_as_int(x), 0x128, 0xf, 0xf, false));
    x += __int_as_float(__builtin_amdgcn_update_dpp(0, __float_as_int(x), 0x124, 0xf, 0xf, false));
    x += __int_as_float(__builtin_amdgcn_update_dpp(0, __float_as_int(x), 0x122, 0xf, 0xf, false));
    x += __int_as_float(__builtin_amdgcn_update_dpp(0, __float_as_int(x), 0x121, 0xf, 0xf, false));
    return xsum32(xsum16(x));
}
#ifndef WT_STORES
#define WT_STORES 0
#endif
DI void st8(void* p, u32x2 v) {
#if WT_STORES
    __hip_atomic_store((unsigned long long*)p, ((unsigned long long)v.y << 32) | v.x, __ATOMIC_RELAXED, __HIP_MEMORY_SCOPE_AGENT);
#else
    *(u32x2*)p = v;
#endif
}
DI void st16(void* p, u32x4 v) {
#if WT_STORES
    u32x2 a = {v.x, v.y}, b = {v.z, v.w}; st8(p, a); st8((char*)p + 8, b);
#else
    *(u32x4*)p = v;
#endif
}
DI void st16f(void* p, f32x4 v) { u32x4 w = {__float_as_uint(v[0]), __float_as_uint(v[1]), __float_as_uint(v[2]), __float_as_uint(v[3])}; st16(p, w); }
#define OPAQUE_IDS() int tid_o = threadIdx.x; asm volatile("" : "+v"(tid_o)); int bid_o = blockIdx.x; asm volatile("" : "+s"(bid_o)); int gdim_o = gridDim.x; asm volatile("" : "+s"(gdim_o))
constexpr int MROWS = 12288, DM = 1024, MP = 4096;
constexpr int NT = 512;
constexpr int LDS_BYTES = 131072;
constexpr size_t OFF_WT_IN_EVEN = 0;
constexpr size_t OFF_WT_OUT_EVEN = OFF_WT_IN_EVEN + 2304ull * 1024 * 2;
constexpr size_t OFF_WT_IN_ODD = OFF_WT_OUT_EVEN + 1024ull * 1024 * 2;
constexpr size_t OFF_WT_OUT_ODD = OFF_WT_IN_ODD + 2048ull * 1024 * 2;
constexpr size_t OFF_WT_UP = OFF_WT_OUT_ODD + 1024ull * 1024 * 2;
constexpr size_t SZ_WT_UP = 5632ull * 1024 * 2;
constexpr size_t OFF_WT_DOWN = OFF_WT_UP + 2 * SZ_WT_UP;
constexpr size_t SZ_WT_DOWN = 1024ull * 2816 * 2;
constexpr size_t OFF_WSP = OFF_WT_DOWN + 2 * SZ_WT_DOWN;
constexpr size_t OFF_KC = OFF_WSP + 8ull * 128 * 128 * 2;
constexpr size_t OFF_VCT = OFF_KC + 4ull * 512 * 128 * 2;
constexpr size_t OFF_ROPE = OFF_VCT + 4ull * 512 * 128 * 2;
constexpr size_t OFF_MOD = OFF_ROPE + 64ull * 16 * 8;
constexpr size_t OFF_RSS = OFF_MOD + 2ull * 5 * 6144 * 4;
constexpr size_t OFF_GS = OFF_RSS + 4ull * 12288 * 4;
constexpr size_t OFF_SW = OFF_GS + 3ull * 5 * 1024 * 4;
constexpr size_t OFF_BAR = ((OFF_SW + 5ull * 13312 * 4 + 4095) / 4096) * 4096;
constexpr size_t BAR_BYTES = 16384;
constexpr size_t OFF_ACT = OFF_BAR + BAR_BYTES;
constexpr size_t OFF_U = OFF_ACT + (size_t)MROWS * 2816 * 2;
constexpr size_t OFF_Q = OFF_U;
constexpr size_t OFF_KB = OFF_Q + (size_t)MROWS * 512 * 2;
constexpr size_t OFF_VT = OFF_KB + (size_t)MROWS * 128 * 2;
constexpr size_t OFF_BCH = OFF_VT + (size_t)MROWS * 128 * 2;
constexpr size_t OFF_MIX = OFF_BCH + (size_t)MROWS * 1536 * 2;
constexpr size_t OFF_UG = OFF_U;
constexpr size_t OFF_V1 = OFF_UG + (size_t)MROWS * 1024 * 2;
constexpr size_t OFF_EDGE = OFF_U;
constexpr size_t OFF_H = OFF_U + 84ull * 1024 * 1024;
constexpr size_t OFF_XB = OFF_U + 109ull * 1024 * 1024;
static_assert(OFF_MIX + (size_t)MROWS * 1024 * 2 <= OFF_H && OFF_H + (size_t)MROWS * 1024 * 2 <= OFF_XB && OFF_XB + (size_t)MROWS * 1024 * 2 <= 256ull * 1024 * 1024, "layout");
static_assert(OFF_V1 + (size_t)MROWS * 1024 * 2 <= OFF_MIX, "layout");


struct KArgs { const float* in[24]; float* out; unsigned char* ws; int ph_lo, ph_hi; };
constexpr int PTAB_OFF = LDS_BYTES;
struct Params {
    LAS unsigned long long* tab;
    DI unsigned long long raw(int i) const { const unsigned long long v = tab[i]; const unsigned lo = __builtin_amdgcn_readfirstlane((unsigned)v), hi = __builtin_amdgcn_readfirstlane((unsigned)(v >> 32)); return ((unsigned long long)hi << 32) | lo; }
    DI const float* in(int i) const { return (const float*)(const __attribute__((address_space(1))) float*)raw(i); }
    DI float* outp() const { return (float*)(__attribute__((address_space(1))) float*)raw(24); }
    DI unsigned char* wsp() const { return (unsigned char*)(__attribute__((address_space(1))) unsigned char*)raw(25); }
};
#define x_prompt in(0)
#define x_sample in(1)
#define cache_k in(2)
#define cache_v in(3)
#define c_lat in(4)
#define c_ctx in(5)
#define ada_w in(6)
#define ada_b in(7)
#define norm_mix_g in(8)
#define norm_ffn_g in(9)
#define w_in_even in(10)
#define q_norm_g in(11)
#define k_norm_g in(12)
#define sink_logit in(13)
#define short_conv_w in(14)
#define w_out_even in(15)
#define w_in_odd in(16)
#define gmlp_norm_g in(17)
#define w_spatial in(18)
#define b_spatial in(19)
#define w_out_odd in(20)
#define w_up in(21)
#define ffn_conv_w in(22)
#define w_down in(23)

constexpr int BM = 256, BK = 64, HALF = 128, HTB = HALF * BK * 2, NXCD = 8, WGM = 8;
DI int lds_byte(int r, int c) { const int st = (r >> 4) * 2 + (c >> 5), rr = r & 15, cc = c & 31, ob = rr * 64 + cc * 2; return st * 1024 + (ob ^ (((ob >> 9) & 1) << 5)); }
DI void stage_rc(int b, int& R, int& C) { const int st = b / 1024, sb = b % 1024, swz = sb ^ (((sb >> 9) & 1) << 5); R = (st >> 1) * 16 + swz / 64; C = (st & 1) * 32 + (swz % 64) / 2; }
DI int perm32(int rho) { const int n = rho >> 4, i = rho & 15; return 8 * (i >> 2) + 4 * n + (i & 3); }
struct Unit { int pm, pn; };
struct Gemm { const bf16_t* A; const bf16_t* Bt; int M, N, K; };
struct StaticOrder {
    int nM, nN, nwg, G, c;
    DI void init(int M, int N, int G_, int c_) { nM = M / BM; nN = N / BM; nwg = nM * nN; G = G_; c = c_; }
    DI bool next(int i, Unit& u) const {
        const long L = (long)i * G + c; if (L >= nwg) return false;
        int wgid = (int)L; { const int q = nwg / NXCD, r = nwg % NXCD, xcd = wgid % NXCD, off = wgid / NXCD; wgid = (xcd < r ? xcd * (q + 1) : r * (q + 1) + (xcd - r) * q) + off; }
        const int nig = WGM * nN, gid = wgid / nig, fm = gid * WGM, gsz = (nM - fm) < WGM ? (nM - fm) : WGM;
        u.pm = fm + ((wgid % nig) % gsz); u.pn = (wgid % nig) / gsz; return true;
    }
};

template <class Epi>
DI void gemm_phase(LAS unsigned char* lds, const Gemm g, const Epi& E) {
    OPAQUE_IDS();
    const int tid = tid_o, wid = __builtin_amdgcn_readfirstlane(tid >> 6), lane = tid & 63, wr = wid >> 2, wc = wid & 3, fr = lane & 15, fq = lane >> 4;
    const int K = g.K, nt = K / BK;
    StaticOrder S; S.init(g.M, g.N, gdim_o, bid_o);
    unsigned voffA[2], voffB[2];
#pragma unroll
    for (int i = 0; i < 2; ++i) { int R, C; stage_rc(tid * 16 + i * 8192, R, C); const int Rb = Epi::PERM ? ((R & ~31) + perm32(R & 31)) : R;
        voffA[i] = (unsigned)(R * K + C) * 2u; voffB[i] = (unsigned)(Rb * K + C) * 2u; }
    const size_t kstep = (size_t)(BK * 2);
    const size_t hstep = (size_t)HALF * K * 2;
    const size_t tstep = 2 * hstep;
    const unsigned ldsw = (unsigned)wid * 1024u;
    const int aoff = lds_byte(wr * 64 + fr, fq * 8), boff = lds_byte(wc * 32 + fr, fq * 8);
#define PG8_SA(b, h) (((b) * 2 + (h)) * HTB)
#define PG8_SB(b, h) ((4 + (b) * 2 + (h)) * HTB)
#define PG8_STAGE(bufoff, gbase, voff) do { _Pragma("unroll") for (int _i = 0; _i < 2; ++_i) \
        __builtin_amdgcn_global_load_lds((const unsigned*)((const char*)(gbase) + (voff)[_i]), (LAS unsigned*)(lds + (bufoff) + ldsw + _i * 8192), 16, 0, 0); } while (0)
#define PG8_LDA(dst, b, h) do { _Pragma("unroll") for (int m = 0; m < 4; ++m) _Pragma("unroll") for (int k = 0; k < 2; ++k) dst[m][k] = *(const LAS bf16x8*)(lds + PG8_SA(b, h) + aoff + m * 2048 + k * 1024); } while (0)
#define PG8_LDB(dst, b, h) do { _Pragma("unroll") for (int n = 0; n < 2; ++n) _Pragma("unroll") for (int k = 0; k < 2; ++k) dst[n][k] = *(const LAS bf16x8*)(lds + PG8_SB(b, h) + boff + n * 2048 + k * 1024); } while (0)
#define PG8_MMA(ai, bj, At, Bt) do { __builtin_amdgcn_s_setprio(1); _Pragma("unroll") for (int m = 0; m < 4; ++m) _Pragma("unroll") for (int n = 0; n < 2; ++n) _Pragma("unroll") for (int k = 0; k < 2; ++k) \
        acc[ai][bj][m][n] = __builtin_amdgcn_mfma_f32_16x16x32_bf16(Bt[n][k], At[m][k], acc[ai][bj][m][n], 0, 0, 0); __builtin_amdgcn_s_setprio(0); } while (0)
#define PG8_WAIT_V(n) asm volatile("s_waitcnt vmcnt(" #n ")" ::: "memory")
#define PG8_WAIT_L(n) asm volatile("s_waitcnt lgkmcnt(" #n ")" ::: "memory")
#define PG8_BAR __builtin_amdgcn_s_barrier()
#define PG8_SCHED __builtin_amdgcn_sched_barrier(0)
    Unit cur, nxt; int ui = 0;
    if (!S.next(0, cur)) return;
    f32x4 acc[2][2][4][2];
#pragma unroll
    for (int a = 0; a < 2; ++a)
#pragma unroll
        for (int b = 0; b < 2; ++b)
#pragma unroll
            for (int m = 0; m < 4; ++m)
#pragma unroll
                for (int n = 0; n < 2; ++n) acc[a][b][m][n] = (f32x4){0.f, 0.f, 0.f, 0.f};
    bf16x8 At[4][2], B0[2][2], B1[2][2];
    const char* cA = (const char*)g.A + (size_t)cur.pm * tstep; const char* cB = (const char*)g.Bt + (size_t)cur.pn * tstep;
    PG8_STAGE(PG8_SB(0, 0), cB, voffB); PG8_STAGE(PG8_SA(0, 0), cA, voffA); PG8_STAGE(PG8_SB(0, 1), cB + hstep, voffB); PG8_STAGE(PG8_SA(0, 1), cA + hstep, voffA);
    if (wr == 1) PG8_BAR;
    PG8_WAIT_V(4); PG8_BAR;
    PG8_STAGE(PG8_SB(1, 0), cB + kstep, voffB); PG8_STAGE(PG8_SA(1, 0), cA + kstep, voffA); PG8_STAGE(PG8_SB(1, 1), cB + hstep + kstep, voffB);
    PG8_WAIT_V(6); PG8_BAR;
    for (;;) {
        const bool has_next = S.next(ui + 1, nxt);
        const char* nA = has_next ? (const char*)g.A + (size_t)nxt.pm * tstep : cA; const char* nB = has_next ? (const char*)g.Bt + (size_t)nxt.pn * tstep : cB;
        for (int t = 0; t < nt; t += 2) {
            const bool last = (t == nt - 2);
            const char* a1 = cA + (size_t)(t + 1) * kstep;
            const char* a2 = last ? nA : cA + (size_t)(t + 2) * kstep; const char* b2 = last ? nB : cB + (size_t)(t + 2) * kstep;
            const char* a3 = a2 + kstep; const char* b3 = b2 + kstep;
            PG8_LDB(B0, 0, 0); PG8_SCHED; PG8_LDA(At, 0, 0); PG8_STAGE(PG8_SA(1, 1), a1 + hstep, voffA);
            PG8_WAIT_L(8); PG8_BAR; PG8_WAIT_L(0); PG8_MMA(0, 0, At, B0); PG8_BAR; PG8_SCHED;
            PG8_LDB(B1, 0, 1); PG8_STAGE(PG8_SB(0, 0), b2, voffB);
            PG8_BAR; PG8_WAIT_L(0); PG8_MMA(0, 1, At, B1); PG8_BAR;
            PG8_LDA(At, 0, 1); PG8_STAGE(PG8_SA(0, 0), a2, voffA);
            PG8_BAR; PG8_WAIT_L(0); PG8_MMA(1, 0, At, B0); PG8_BAR; PG8_SCHED;
            PG8_STAGE(PG8_SB(0, 1), b2 + hstep, voffB);
            PG8_WAIT_V(6); PG8_BAR; PG8_MMA(1, 1, At, B1); PG8_BAR;
            PG8_LDB(B0, 1, 0); PG8_SCHED; PG8_LDA(At, 1, 0); PG8_STAGE(PG8_SA(0, 1), a2 + hstep, voffA);
            PG8_WAIT_L(8); PG8_BAR; PG8_WAIT_L(0); PG8_MMA(0, 0, At, B0); PG8_BAR; PG8_SCHED;
            PG8_LDB(B1, 1, 1); PG8_STAGE(PG8_SB(1, 0), b3, voffB);
            PG8_BAR; PG8_WAIT_L(0); PG8_MMA(0, 1, At, B1); PG8_BAR;
            PG8_LDA(At, 1, 1); PG8_STAGE(PG8_SA(1, 0), a3, voffA);
            PG8_BAR; PG8_WAIT_L(0); PG8_MMA(1, 0, At, B0); PG8_BAR; PG8_SCHED;
            PG8_STAGE(PG8_SB(1, 1), b3 + hstep, voffB);
            PG8_WAIT_V(6); PG8_BAR; PG8_MMA(1, 1, At, B1); PG8_BAR;
        }
        E(acc, cur, wr, wc, fr, fq);
        if (!has_next) break;
#pragma unroll
        for (int a = 0; a < 2; ++a)
#pragma unroll
            for (int b = 0; b < 2; ++b)
#pragma unroll
                for (int m = 0; m < 4; ++m)
#pragma unroll
                    for (int n = 0; n < 2; ++n) acc[a][b][m][n] = (f32x4){0.f, 0.f, 0.f, 0.f};
        cur = nxt; cA = nA; cB = nB; ++ui;
    }
    PG8_WAIT_V(0);
    if (wr == 0) PG8_BAR;
    PG8_BAR;
#undef PG8_SA
#undef PG8_SB
#undef PG8_STAGE
#undef PG8_LDA
#undef PG8_LDB
#undef PG8_MMA
#undef PG8_WAIT_V
#undef PG8_WAIT_L
#undef PG8_BAR
#undef PG8_SCHED
}

struct EpiInEven {
    static constexpr bool PERM = false;
    bf16_t *Q, *Kb, *Vt, *BCH; float *outK, *outV; const float *qg, *kg; const f32x2* rope;
    DI void operator()(f32x4 (&acc)[2][2][4][2], const Unit& u, int wr, int wc, int fr_, int fq_) const {
        int fr = fr_, fq = fq_; asm volatile("" : "+v"(fr), "+v"(fq));
        const int row0 = u.pm * BM + wr * 64 + fr;
        const bool samp = (u.pm >= 16);
        if (u.pn >= 3) {
            const int cb = u.pn * 256 - 768 + wc * 64 + 8 * fq;
#pragma unroll
            for (int ai = 0; ai < 2; ++ai)
#pragma unroll
                for (int m = 0; m < 4; ++m) { bf16_t* rp = BCH + (size_t)(row0 + ai * HALF + m * 16) * 1536 + cb;
#pragma unroll
                    for (int bj = 0; bj < 2; ++bj) { const f32x4 v0 = acc[ai][bj][m][0], v1 = acc[ai][bj][m][1];
                        u32x4 w; w.x = pk2(v0[0], v0[1]); w.y = pk2(v0[2], v0[3]); w.z = pk2(v1[0], v1[1]); w.w = pk2(v1[2], v1[3]); *(u32x4*)(rp + 32 * bj) = w; } }
            return;
        }
        const bool isv = (u.pn == 2 && wc >= 2);
        if (!isv) {
            const bool isq = u.pn < 2;
            const float* gsrc = isq ? qg : kg;
            f32x4 gg[2][2];
#pragma unroll
            for (int bj = 0; bj < 2; ++bj)
#pragma unroll
                for (int n = 0; n < 2; ++n) gg[bj][n] = *(const f32x4*)(gsrc + 32 * bj + 16 * n + 4 * fq);
            const int head = isq ? u.pn * 4 + wc : wc;
#pragma unroll
            for (int ai = 0; ai < 2; ++ai)
#pragma unroll
                for (int m = 0; m < 4; ++m) {
                    const int row = row0 + ai * HALF + m * 16;
                    float ss = 0.f;
#pragma unroll
                    for (int bj = 0; bj < 2; ++bj)
#pragma unroll
                        for (int n = 0; n < 2; ++n) { const f32x4 v = acc[ai][bj][m][n]; ss += (v[0] * v[0] + v[1] * v[1]) + (v[2] * v[2] + v[3] * v[3]); }
                    ss = xsum32(xsum16(ss));
                    const float rstd = rsqrtf(ss * (1.0f / 64.0f) + 1e-6f);
                    f32x4 v[2][2];
#pragma unroll
                    for (int bj = 0; bj < 2; ++bj)
#pragma unroll
                        for (int n = 0; n < 2; ++n) v[bj][n] = acc[ai][bj][m][n] * rstd * gg[bj][n];
                    if (samp) {
                        const int t = (row - MP) & 2047; const int pr = t >> 6, pc = t & 63;
#pragma unroll
                        for (int bj = 0; bj < 2; ++bj) {
                            const int pos = bj ? pc : pr; const f32x4* rp = (const f32x4*)(rope + pos * 16 + 4 * fq);
                            const f32x4 c01 = rp[0], c23 = rp[1];
                            const float cs[4] = {c01[0], c01[2], c23[0], c23[2]}, sn[4] = {c01[1], c01[3], c23[1], c23[3]};
#pragma unroll
                            for (int e = 0; e < 4; ++e) { const float x1 = v[bj][0][e], x2 = v[bj][1][e]; v[bj][0][e] = x1 * cs[e] - x2 * sn[e]; v[bj][1][e] = x2 * cs[e] + x1 * sn[e]; }
                        }
                    }
                    if (isq) { bf16_t* dp = Q + (size_t)row * 512 + head * 64 + 4 * fq;
#pragma unroll
                        for (int bj = 0; bj < 2; ++bj)
#pragma unroll
                            for (int n = 0; n < 2; ++n) { u32x2 w; w.x = pk2(v[bj][n][0], v[bj][n][1]); w.y = pk2(v[bj][n][2], v[bj][n][3]); st8(dp + 32 * bj + 16 * n, w); } }
                    else {
                        size_t cb; int t;
                        if (!samp) { t = row & 255; cb = (size_t)(((row >> 8) * 2 + head) * 8 + (t >> 5)) * 2048; }
                        else { const int r2 = row - MP; t = r2 & 2047; cb = 524288 + (size_t)(((r2 >> 11) * 2 + head) * 64 + (t >> 5)) * 2048; }
                        bf16_t* dp = Kb + cb + ((fq >> 1) * 32 + (t & 31)) * 8 + 4 * (fq & 1);
#pragma unroll
                        for (int bj = 0; bj < 2; ++bj)
#pragma unroll
                            for (int n = 0; n < 2; ++n) { u32x2 w; w.x = pk2(v[bj][n][0], v[bj][n][1]); w.y = pk2(v[bj][n][2], v[bj][n][3]); *(u32x2*)(dp + (2 * bj + n) * 512) = w; } }
                    if (!isq && !samp) { float* op = outK + ((size_t)row * 2 + head) * 64 + 4 * fq;
#pragma unroll
                        for (int bj = 0; bj < 2; ++bj)
#pragma unroll
                            for (int n = 0; n < 2; ++n) *(f32x4*)(op + 32 * bj + 16 * n) = v[bj][n]; }
                }
        } else {
            const int hv = wc - 2;
#pragma unroll
            for (int ai = 0; ai < 2; ++ai)
#pragma unroll
                for (int m = 0; m < 4; ++m) {
                    const int row = row0 + ai * HALF + m * 16;
                    bf16_t* vb; size_t vs;
                    if (!samp) {
                        float* op = outV + ((size_t)row * 2 + hv) * 64 + 4 * fq;
#pragma unroll
                        for (int bj = 0; bj < 2; ++bj)
#pragma unroll
                            for (int n = 0; n < 2; ++n) *(f32x4*)(op + 32 * bj + 16 * n) = acc[ai][bj][m][n];
                        const int t = row & 255; vb = Vt + (size_t)(((row >> 8) * 2 + hv) * 8 + (t >> 5)) * 2048; vs = t & 31;
                    } else { const int r2 = row - MP; const int t = r2 & 2047; vb = Vt + 524288 + (size_t)(((r2 >> 11) * 2 + hv) * 64 + (t >> 5)) * 2048; vs = t & 31; }
                    { const int tk = (int)vs; const int ks = tk >> 4, kk = tk & 15; vb += (ks * 64 + ((kk >> 2) & 1) * 32) * 8 + 4 * (kk >> 3) + (kk & 3); }
#pragma unroll
                    for (int bj = 0; bj < 2; ++bj)
#pragma unroll
                        for (int n = 0; n < 2; ++n)
#pragma unroll
                            for (int e = 0; e < 4; ++e) vb[(bj * 128 + 16 * n + 4 * fq + e) * 8] = f2bf(acc[ai][bj][m][n][e]);
                }
        }
    }
};

struct EpiResid {
    static constexpr bool PERM = true;
    const float* xp; const float* xs; const bf16_t* xb;
    float* out; bf16_t* outb;
    const float* gate;
    bf16_t* Aout; const float* gs; float* rss;
    DI void operator()(f32x4 (&acc)[2][2][4][2], const Unit& u, int wr, int wc, int fr_, int fq_) const {
        int fr = fr_, fq = fq_; asm volatile("" : "+v"(fr), "+v"(fq));
        const int row0 = u.pm * BM + wr * 64 + fr, col0 = u.pn * BM + wc * 32 + 8 * fq;
        const int cond = u.pm < 16 ? 0 : 1 + ((u.pm - 16) >> 3);
        const float* gp = gate + cond * 6144 + col0;
        f32x4 gv[2][2], gsv[2][2];
#pragma unroll
        for (int bj = 0; bj < 2; ++bj)
#pragma unroll
            for (int n = 0; n < 2; ++n) { gv[bj][n] = *(const f32x4*)(gp + bj * HALF + 4 * n); gsv[bj][n] = Aout ? *(const f32x4*)(gs + cond * 1024 + col0 + bj * HALF + 4 * n) : (f32x4){0.f, 0.f, 0.f, 0.f}; }
#pragma unroll
        for (int ai = 0; ai < 2; ++ai)
#pragma unroll
            for (int m = 0; m < 4; ++m) {
                const int row = row0 + ai * HALF + m * 16;
                const size_t ro = (size_t)row * DM + col0;
                const float* xin = (row < MP ? xp + (size_t)row * DM : xs + (size_t)(row - MP) * DM) + col0;
                float ss = 0.f;
#pragma unroll
                for (int bj = 0; bj < 2; ++bj) { const int co = bj * HALF;
                    f32x4 x0, x1;
                    if (xb) { const u32x4 w = *(const u32x4*)(xb + ro + co); x0 = (f32x4){bflo(w.x), bfhi(w.x), bflo(w.y), bfhi(w.y)}; x1 = (f32x4){bflo(w.z), bfhi(w.z), bflo(w.w), bfhi(w.w)}; }
                    else { x0 = *(const f32x4*)(xin + co); x1 = *(const f32x4*)(xin + co + 4); }
                    const f32x4 n0 = x0 + gv[bj][0] * acc[ai][bj][m][0], n1 = x1 + gv[bj][1] * acc[ai][bj][m][1];
                    if (outb) { u32x4 w; w.x = pk2(n0[0], n0[1]); w.y = pk2(n0[2], n0[3]); w.z = pk2(n1[0], n1[1]); w.w = pk2(n1[2], n1[3]); *(u32x4*)(outb + ro + co) = w; }
                    else { *(f32x4*)(out + ro + co) = n0; *(f32x4*)(out + ro + co + 4) = n1; }
                    if (Aout) { ss += (n0[0] * n0[0] + n0[1] * n0[1]) + (n0[2] * n0[2] + n0[3] * n0[3]) + (n1[0] * n1[0] + n1[1] * n1[1]) + (n1[2] * n1[2] + n1[3] * n1[3]);
                        const f32x4 a0 = n0 * gsv[bj][0], a1 = n1 * gsv[bj][1];
                        u32x4 w; w.x = pk2(a0[0], a0[1]); w.y = pk2(a0[2], a0[3]); w.z = pk2(a1[0], a1[1]); w.w = pk2(a1[2], a1[3]); *(u32x4*)(Aout + ro + co) = w; } }
                if (Aout) { ss = xsum32(xsum16(ss)); if (fq == 0) atomicAdd(rss + row, ss); }
            }
    }
};

DI float silu_f(float x) { return x * __builtin_amdgcn_rcpf(1.0f + __builtin_amdgcn_exp2f(-1.4426950408889634f * x)); }
#define DPP_SHR1(x)  __int_as_float(__builtin_amdgcn_update_dpp(0, __float_as_int(x), 0x111, 0xf, 0xf, true))
#define DPP_SHL1(x)  __int_as_float(__builtin_amdgcn_update_dpp(0, __float_as_int(x), 0x101, 0xf, 0xf, true))
#define DPP_SHL15(x) __int_as_float(__builtin_amdgcn_update_dpp(0, __float_as_int(x), 0x10f, 0xf, 0xf, true))
#define DPP_SHR15(x) __int_as_float(__builtin_amdgcn_update_dpp(0, __float_as_int(x), 0x11f, 0xf, 0xf, true))
struct EpiUpConv {
    static constexpr bool PERM = true;
    bf16_t* ACT; bf16_t* EDGE; const float* cw;
    const float* rss; const float* sw;
    DI void operator()(f32x4 (&acc)[2][2][4][2], const Unit& u, int wr, int wc, int fr_, int fq_) const {
        int fr = fr_, fq = fq_; asm volatile("" : "+v"(fr), "+v"(fq));
        {
            const int cond = u.pm < 16 ? 0 : 1 + ((u.pm - 16) >> 3);
            const float* sp = sw + (size_t)cond * 5632 + u.pn * 256 + wc * 32 + 8 * fq;
            f32x4 swv[2][2];
#pragma unroll
            for (int bj = 0; bj < 2; ++bj)
#pragma unroll
                for (int n = 0; n < 2; ++n) swv[bj][n] = *(const f32x4*)(sp + bj * HALF + 4 * n);
#pragma unroll
            for (int ai = 0; ai < 2; ++ai)
#pragma unroll
                for (int m = 0; m < 4; ++m) { const float rstd = rsqrtf(rss[u.pm * BM + ai * HALF + wr * 64 + 16 * m + fr] * (1.0f / 1024.0f) + 1e-6f);
#pragma unroll
                    for (int bj = 0; bj < 2; ++bj)
#pragma unroll
                        for (int n = 0; n < 2; ++n) acc[ai][bj][m][n] = acc[ai][bj][m][n] * rstd + swv[bj][n]; }
        }
#pragma unroll
        for (int n = 0; n < 2; ++n) {
            const int ch0 = u.pn * 128 + wc * 32 + 8 * fq + 4 * n;
            f32x4 wg[3], wv[3];
#pragma unroll
            for (int tp = 0; tp < 3; ++tp) { wg[tp] = *(const f32x4*)(cw + tp * 5632 + ch0); wv[tp] = *(const f32x4*)(cw + tp * 5632 + 2816 + ch0); }
#pragma unroll
            for (int ai = 0; ai < 2; ++ai) {
                const int rbase = u.pm * BM + ai * HALF + wr * 64;
#pragma unroll
                for (int m = 0; m < 4; ++m) {
                    const int row = rbase + 16 * m + fr;
                    float o[4];
#pragma unroll
                    for (int e = 0; e < 4; ++e) {
                        float cv[2];
#pragma unroll
                        for (int bj = 0; bj < 2; ++bj) {
                            const float x = acc[ai][bj][m][n][e];
                            const float w0 = bj ? wv[0][e] : wg[0][e], w1 = bj ? wv[1][e] : wg[1][e], w2 = bj ? wv[2][e] : wg[2][e];
                            float c = w1 * x;
                            c = __builtin_fmaf(DPP_SHR1(x), w0, c);
                            c = __builtin_fmaf(DPP_SHL1(x), w2, c);
                            if (m > 0) c = __builtin_fmaf(DPP_SHL15(acc[ai][bj][m > 0 ? m - 1 : 0][n][e]), w0, c);
                            if (m < 3) c = __builtin_fmaf(DPP_SHR15(acc[ai][bj][m < 3 ? m + 1 : 3][n][e]), w2, c);
                            cv[bj] = c;
                        }
                        o[e] = cv[0] * cv[1] * __builtin_amdgcn_rcpf(1.0f + __builtin_amdgcn_exp2f(-1.4426950408889634f * cv[0]));
                    }
                    const bool edge = (m == 0 && fr == 0) || (m == 3 && fr == 15);
                    if (!edge) { u32x2 w; w.x = pk2(o[0], o[1]); w.y = pk2(o[2], o[3]); st8(ACT + (size_t)row * 2816 + ch0, w); }
                    if ((m == 0 && fr < 2) || (m == 3 && fr >= 14)) {
                        const int slot = (m == 0) ? fr : fr - 12;
                        bf16_t* ep = EDGE + (size_t)((row >> 6) * 4 + slot) * 5632 + ch0;
                        const f32x4 g0 = acc[ai][0][m][n], v0 = acc[ai][1][m][n];
                        u32x2 w; w.x = pk2(g0[0], g0[1]); w.y = pk2(g0[2], g0[3]); *(u32x2*)ep = w;
                        u32x2 w2; w2.x = pk2(v0[0], v0[1]); w2.y = pk2(v0[2], v0[3]); *(u32x2*)(ep + 2816) = w2;
                    }
                }
            }
        }
    }
};

DI float gelu_tanh(float x) {
    const float y = (1.5957691216057308f * 1.4426950408889634f) * (x + 0.044715f * x * x * x);
    return x * __builtin_amdgcn_rcpf(1.0f + __builtin_amdgcn_exp2f(-y));
}
struct EpiInOdd {
    static constexpr bool PERM = true;
    bf16_t *UG, *V1; float* rss; const float* rssx; const float* sw;
    DI void operator()(f32x4 (&acc)[2][2][4][2], const Unit& u, int wr, int wc, int fr_, int fq_) const {
        int fr = fr_, fq = fq_; asm volatile("" : "+v"(fr), "+v"(fq));
        const int row0 = u.pm * BM + wr * 64 + fr, col0 = (u.pn & 3) * BM + wc * 32 + 8 * fq;
        const bool isv = u.pn >= 4;
        bf16_t* dst = isv ? V1 : UG;
        const int cond = u.pm < 16 ? 0 : 1 + ((u.pm - 16) >> 3);
        const float* sp = sw + (size_t)cond * 2048 + u.pn * 256 + wc * 32 + 8 * fq;
        f32x4 swv[2][2];
#pragma unroll
        for (int bj = 0; bj < 2; ++bj)
#pragma unroll
            for (int n = 0; n < 2; ++n) swv[bj][n] = *(const f32x4*)(sp + bj * HALF + 4 * n);
#pragma unroll
        for (int ai = 0; ai < 2; ++ai)
#pragma unroll
            for (int m = 0; m < 4; ++m) { const int row = row0 + ai * HALF + m * 16; bf16_t* rp = dst + (size_t)row * 1024 + col0; float ss = 0.f;
                const float rstd = rsqrtf(rssx[row] * (1.0f / 1024.0f) + 1e-6f);
#pragma unroll
                for (int bj = 0; bj < 2; ++bj) { f32x4 v0 = acc[ai][bj][m][0] * rstd + swv[bj][0], v1 = acc[ai][bj][m][1] * rstd + swv[bj][1];
#pragma unroll
                    for (int e = 0; e < 4; ++e) { v0[e] = gelu_tanh(v0[e]); v1[e] = gelu_tanh(v1[e]); ss += v0[e] * v0[e] + v1[e] * v1[e]; }
                    u32x4 w; w.x = pk2(v0[0], v0[1]); w.y = pk2(v0[2], v0[3]); w.z = pk2(v1[0], v1[1]); w.w = pk2(v1[2], v1[3]); st16(rp + bj * HALF, w); }
                if (isv) { ss = xsum32(xsum16(ss)); if (fq == 0) atomicAdd(rss + row, ss); }
            }
    }
};


DI void adaln_prep(const Params& p, LAS unsigned char* lds, int tid) {
    LAS float* S = (LAS float*)(lds + 66048);
    for (int i = tid; i < 5 * 1024; i += NT) { const int cd = i >> 10, k = i & 1023; const float v = cd == 0 ? p.c_ctx[k] : p.c_lat[(cd - 1) * 1024 + k]; S[i] = silu_f(v); }
    __syncthreads();
}
DI void adaln_task(const Params& p, LAS unsigned char* lds, int tid, int task) {
    LAS float* S = (LAS float*)(lds + 66048);
    LAS float* P = (LAS float*)(lds + 66048 + 20480);
    float* mod = (float*)(p.wsp() + OFF_MOD);
    const int cgp = tid & 7, kg = tid >> 3;
    const int l = task / 192, cc = task % 192;
    const float* wp = p.ada_w + ((size_t)l * 1024 + kg * 16) * 6144 + cc * 32 + 4 * cgp;
    f32x4 a[5];
#pragma unroll
    for (int cd = 0; cd < 5; ++cd) a[cd] = (f32x4){0.f, 0.f, 0.f, 0.f};
#pragma unroll
    for (int kk = 0; kk < 16; ++kk) { const f32x4 w = __builtin_nontemporal_load((const f32x4*)(wp + (size_t)kk * 6144));
#pragma unroll
        for (int cd = 0; cd < 5; ++cd) a[cd] += w * S[cd * 1024 + kg * 16 + kk]; }
#pragma unroll
    for (int cd = 0; cd < 5; ++cd)
#pragma unroll
        for (int e = 0; e < 4; ++e) P[(kg * 8 + cgp) * 20 + cd * 4 + e] = a[cd][e];
    __syncthreads();
    if (tid < 160) { const int cd = tid >> 5, col = tid & 31, cg2 = col >> 2, e = col & 3; float sacc = 0.f;
        for (int k2 = 0; k2 < 64; ++k2) sacc += P[(k2 * 8 + cg2) * 20 + cd * 4 + e];
        mod[(size_t)(l * 5 + cd) * 6144 + cc * 32 + col] = sacc + p.ada_b[l * 6144 + cc * 32 + col]; }
    __syncthreads();
}
DI void transpose_tile(const Params& p, LAS unsigned char* lds, int tid, int tile) {
    unsigned char* ws = p.wsp();
    LAS float* T = (LAS float*)lds;
    int t = tile; const float* src; bf16_t* dst; int K, N, perm = 0;
    if (t < 144) { src = p.w_in_even; dst = (bf16_t*)(ws + OFF_WT_IN_EVEN); K = 1024; N = 2304; perm = 1; }
    else if ((t -= 144) < 64) { src = p.w_out_even; dst = (bf16_t*)(ws + OFF_WT_OUT_EVEN); K = 1024; N = 1024; }
    else if ((t -= 64) < 128) { src = p.w_in_odd; dst = (bf16_t*)(ws + OFF_WT_IN_ODD); K = 1024; N = 2048; }
    else if ((t -= 128) < 64) { src = p.w_out_odd; dst = (bf16_t*)(ws + OFF_WT_OUT_ODD); K = 1024; N = 1024; }
    else if ((t -= 64) < 352) { src = p.w_up; dst = (bf16_t*)(ws + OFF_WT_UP); K = 1024; N = 5632; perm = 2; }
    else if ((t -= 352) < 352) { src = p.w_up + (size_t)1024 * 5632; dst = (bf16_t*)(ws + OFF_WT_UP + SZ_WT_UP); K = 1024; N = 5632; perm = 2; }
    else if ((t -= 352) < 176) { src = p.w_down; dst = (bf16_t*)(ws + OFF_WT_DOWN); K = 2816; N = 1024; }
    else { t -= 176; src = p.w_down + (size_t)2816 * 1024; dst = (bf16_t*)(ws + OFF_WT_DOWN + SZ_WT_DOWN); K = 2816; N = 1024; }
    const int tn = N >> 8; const int tk = t / tn, tnn = t - tk * tn; const int k0 = tk * 64, n0 = tnn * 256;
    {
        const int c4 = tid & 63, r0 = tid >> 6;
        f32x4 v[8];
#pragma unroll
        for (int i = 0; i < 8; ++i) v[i] = __builtin_nontemporal_load((const f32x4*)(src + (size_t)(k0 + r0 + 8 * i) * N + n0 + 4 * c4));
#pragma unroll
        for (int i = 0; i < 8; ++i) { LAS float* tp = T + (r0 + 8 * i) * 257 + 4 * c4; tp[0] = v[i][0]; tp[1] = v[i][1]; tp[2] = v[i][2]; tp[3] = v[i][3]; }
    }
    __syncthreads();
    {
        const int n = tid & 255, kh = tid >> 8;
        const int oc = n0 + n;
        int gcol = oc;
        if (perm == 1) { const int w32 = oc & 31;
            const int in32 = oc >= 768 ? 16 * ((w32 >> 2) & 1) + 4 * (w32 >> 3) + (w32 & 3) : w32;
            gcol = (oc & ~255) + ((oc >> 5) & 1) * 128 + ((oc >> 6) & 3) * 32 + in32; }
        if (perm == 2) { const int isv = oc >= 2816, j = isv ? oc - 2816 : oc; gcol = (j >> 7) * 256 + isv * 128 + (j & 127); }
        bf16_t* dp = dst + (size_t)gcol * K + k0 + 32 * kh;
#pragma unroll
        for (int q = 0; q < 4; ++q) { float f[8];
#pragma unroll
            for (int j = 0; j < 8; ++j) f[j] = T[(32 * kh + 8 * q + j) * 257 + n];
            *(u32x4*)(dp + 8 * q) = pack8(f); }
    }
    __syncthreads();
}
DI void wspatial_job(const Params& p, int tid, int j) {
    bf16_t* wsp = (bf16_t*)(p.wsp() + OFF_WSP);
    for (int i = j * 2048 + tid; i < (j + 1) * 2048; i += NT) { const f32x4 a = *(const f32x4*)(p.w_spatial + (size_t)i * 8), b = *(const f32x4*)(p.w_spatial + (size_t)i * 8 + 4);
        u32x4 w; w.x = pk2(a[0], a[1]); w.y = pk2(a[2], a[3]); w.z = pk2(b[0], b[1]); w.w = pk2(b[2], b[3]); *(u32x4*)(wsp + (size_t)i * 8) = w; }
}
DI void sw_chunk(const Params& p, int chunk, int lane) {
    unsigned char* ws = p.wsp();
    const float* mod = (const float*)(ws + OFF_MOD); float* SW = (float*)(ws + OFF_SW);
    const int r0 = chunk * 8;
    const bf16_t* wt; const float* sh; int nloc; float* dst; int N;
    if (r0 < 5632) { wt = (const bf16_t*)(ws + OFF_WT_UP); sh = mod + 3 * 1024; nloc = r0; dst = SW; N = 5632; }
    else if (r0 < 7680) { wt = (const bf16_t*)(ws + OFF_WT_IN_ODD); sh = mod + 5 * 6144; nloc = r0 - 5632; dst = SW + 5 * 5632; N = 2048; }
    else { wt = (const bf16_t*)(ws + OFF_WT_UP + SZ_WT_UP); sh = mod + 5 * 6144 + 3 * 1024; nloc = r0 - 7680; dst = SW + 5 * 7680; N = 5632; }
    float shv[5][16];
#pragma unroll
    for (int cd = 0; cd < 5; ++cd)
#pragma unroll
        for (int q = 0; q < 4; ++q) { const f32x4 v = *(const f32x4*)(sh + (size_t)cd * 6144 + lane * 16 + 4 * q); shv[cd][4 * q] = v[0]; shv[cd][4 * q + 1] = v[1]; shv[cd][4 * q + 2] = v[2]; shv[cd][4 * q + 3] = v[3]; }
    for (int rr = 0; rr < 8; ++rr) {
        const bf16_t* rp = wt + (size_t)(nloc + rr) * 1024 + lane * 16;
        const u32x4 wa = *(const u32x4*)rp, wb = *(const u32x4*)(rp + 8);
        float wf[16]; { float t8[8]; unpack8(wa, t8);
#pragma unroll
            for (int j = 0; j < 8; ++j) wf[j] = t8[j];
            unpack8(wb, t8);
#pragma unroll
            for (int j = 0; j < 8; ++j) wf[8 + j] = t8[j]; }
        float acc5[5];
#pragma unroll
        for (int cd = 0; cd < 5; ++cd) { float a = 0.f;
#pragma unroll
            for (int j = 0; j < 16; ++j) a += shv[cd][j] * wf[j];
            acc5[cd] = wave_sum(a); }
        if (lane == 0) {
#pragma unroll
            for (int cd = 0; cd < 5; ++cd) dst[(size_t)cd * N + nloc + rr] = acc5[cd]; }
    }
}
DI void gs_tables(const Params& p, int t_lo, int t_hi, int gtid, int gsz) {
    unsigned char* ws = p.wsp();
    const float* mod = (const float*)(ws + OFF_MOD); float* GS = (float*)(ws + OFF_GS);
    for (int i = t_lo * 5120 + gtid; i < t_hi * 5120; i += gsz) { const int t = i / 5120, cd = (i / 1024) % 5, k = i & 1023;
        const float g = t == 0 ? p.norm_ffn_g[k] : (t == 1 ? p.norm_mix_g[1024 + k] : p.norm_ffn_g[1024 + k]);
        const float sc = mod[(size_t)((t == 0 ? 0 : 5) + cd) * 6144 + (t == 1 ? 1 : 4) * 1024 + k];
        GS[i] = g * (1.0f + sc); }
}

DI void bg_run(const Params& p, LAS unsigned char* lds, int q) {
    OPAQUE_IDS();
    (void)bid_o; (void)gdim_o;
    const int tid = tid_o;
    unsigned* ctr = (unsigned*)(p.wsp() + OFF_BAR) + 16 * q;
    volatile LAS int* slot = (volatile LAS int*)(lds + PTAB_OFF + 248);
    const int njobs = q == 0 ? 592 : (q == 1 ? 280 : (q == 2 ? 728 : 120));
    bool prepped = false;
    for (;;) {
        if (tid == 0) *slot = (int)__hip_atomic_fetch_add(ctr, 1u, __ATOMIC_RELAXED, __HIP_MEMORY_SCOPE_AGENT);
        __syncthreads();
        const int j = *slot;
        __syncthreads();
        if (j >= njobs) break;
        if (q == 0) { const int tile = j < 64 ? 144 + j : (j < 416 ? 400 + (j - 64) : 1104 + (j - 416)); transpose_tile(p, lds, tid, tile); }
        else if (q == 1) {
            if (j < 192) { if (!prepped) { adaln_prep(p, lds, tid); prepped = true; } adaln_task(p, lds, tid, 192 + j); }
            else sw_chunk(p, (j - 192) * 8 + (tid >> 6), tid & 63);
        } else if (q == 2) {
            if (j < 720) { const int tile = j < 192 ? 208 + j : (j < 544 ? 752 + (j - 192) : 1280 + (j - 544)); transpose_tile(p, lds, tid, tile); }
            else wspatial_job(p, tid, j - 720);
        } else sw_chunk(p, 704 + j * 8 + (tid >> 6), tid & 63);
    }
}

DI void gs_l1_phase(const Params& p) { OPAQUE_IDS(); gs_tables(p, 1, 3, bid_o * NT + tid_o, gdim_o * NT); }
DI bool has_unit_n1024() { OPAQUE_IDS(); (void)tid_o; StaticOrder S; S.init(MROWS, 1024, gdim_o, bid_o); Unit u0; return S.next(0, u0); }

DI void phase0(const Params& p, LAS unsigned char* lds) {
    OPAQUE_IDS();
    const int tid = tid_o;
    unsigned char* ws = p.wsp();
    { float* rss = (float*)(ws + OFF_RSS); for (int i = bid_o * NT + tid; i < 4 * MROWS; i += gdim_o * NT) rss[i] = 0.f; }
    adaln_prep(p, lds, tid);
    for (int task = bid_o; task < 192; task += gdim_o) adaln_task(p, lds, tid, task);
    for (int j = gdim_o - 1 - bid_o; j < 144; j += gdim_o) transpose_tile(p, lds, tid, j);
    const int gtid = bid_o * NT + tid, gsz = gdim_o * NT;
    { bf16_t* kc = (bf16_t*)(ws + OFF_KC);
      for (int i = gtid; i < 32768; i += gsz) { const int r = i & 31, h = (i >> 5) & 1, sst = (i >> 6) & 3, chunk = (i >> 8) & 15, hk = (i >> 12) & 1, b = i >> 13;
          const float* sp = p.cache_k + ((size_t)(b * 512 + chunk * 32 + r) * 2 + hk) * 64 + sst * 16 + h * 8;
          const f32x4 a = *(const f32x4*)sp, bb = *(const f32x4*)(sp + 4);
          u32x4 w; w.x = pk2(a[0], a[1]); w.y = pk2(a[2], a[3]); w.z = pk2(bb[0], bb[1]); w.w = pk2(bb[2], bb[3]); *(u32x4*)(kc + (size_t)i * 8) = w; } }
    { bf16_t* vct = (bf16_t*)(ws + OFF_VCT);
      for (int i = gtid; i < 32768; i += gsz) { const int lr = i & 31, hh = (i >> 5) & 1, ks = (i >> 6) & 1, db = (i >> 7) & 1, chunk = (i >> 8) & 15, hk = (i >> 12) & 1, b = i >> 13; float f[8];
#pragma unroll
          for (int j = 0; j < 8; ++j) { const int key = chunk * 32 + 16 * ks + 8 * (j >> 2) + 4 * hh + (j & 3); f[j] = p.cache_v[((size_t)(b * 512 + key) * 2 + hk) * 64 + 32 * db + lr]; }
          *(u32x4*)(vct + (size_t)i * 8) = pack8(f); } }
    { f32x2* rope = (f32x2*)(ws + OFF_ROPE);
      for (int i = gtid; i < 1024; i += gsz) { const int pos = i >> 4, f = i & 15; const float inv = powf(10000.0f, -(float)f / 16.0f); const float ang = (float)pos * inv;
          float sv, cv; sincosf(ang, &sv, &cv); rope[i] = (f32x2){cv, sv}; } }
}

DI void modulate_phase(const float* xp, const float* xs, const float* g, const float* mod_l  , int shift_i, bf16_t* H) {
    OPAQUE_IDS();
    const int tid = tid_o, wid = tid >> 6, lane = tid & 63;
    const int W = gdim_o * 8;
    for (int row = bid_o * 8 + wid; row < MROWS; row += W) {
        const float* xr = row < MP ? xp + (size_t)row * DM : xs + (size_t)(row - MP) * DM;
        const int cond = row < MP ? 0 : 1 + ((row - MP) >> 11);
        f32x4 v[4]; float ss = 0.f;
#pragma unroll
        for (int i = 0; i < 4; ++i) { v[i] = __builtin_nontemporal_load((const f32x4*)(xr + 512 * (i >> 1) + 8 * lane + 4 * (i & 1))); ss += (v[i][0] * v[i][0] + v[i][1] * v[i][1]) + (v[i][2] * v[i][2] + v[i][3] * v[i][3]); }
        ss = wave_sum(ss);
        const float rstd = rsqrtf(ss * (1.0f / 1024.0f) + 1e-6f);
        const float* sh = mod_l + (size_t)cond * 6144 + shift_i * 1024; const float* sc = sh + 1024;
#pragma unroll
        for (int i2 = 0; i2 < 2; ++i2) { const int col = 512 * i2 + 8 * lane; f32x4 h[2];
#pragma unroll
            for (int q = 0; q < 2; ++q) { const f32x4 gg = *(const f32x4*)(g + col + 4 * q), s1 = *(const f32x4*)(sc + col + 4 * q), s0 = *(const f32x4*)(sh + col + 4 * q);
                h[q] = v[2 * i2 + q] * rstd * gg * (s1 + 1.0f) + s0; }
            u32x4 w; w.x = pk2(h[0][0], h[0][1]); w.y = pk2(h[0][2], h[0][3]); w.z = pk2(h[1][0], h[1][1]); w.w = pk2(h[1][2], h[1][3]); *(u32x4*)(H + (size_t)row * DM + col) = w; }
    }
}

DI void tables_phase(const Params& p) {
    OPAQUE_IDS();
    gs_tables(p, 0, 1, bid_o * NT + tid_o, gdim_o * NT);
}

#define MFMA32(a, b, c) __builtin_amdgcn_mfma_f32_32x32x16_bf16((a), (b), (c), 0, 0, 0)
DI void attn_phase(const Params& p) {
    OPAQUE_IDS();
    unsigned char* ws = p.wsp();
    const bf16_t* Q = (const bf16_t*)(ws + OFF_Q); const bf16_t* Kb = (const bf16_t*)(ws + OFF_KB); const bf16_t* Vt = (const bf16_t*)(ws + OFF_VT);
    const bf16_t* BCH = (const bf16_t*)(ws + OFF_BCH); const bf16_t* Kc = (const bf16_t*)(ws + OFF_KC); const bf16_t* Vct = (const bf16_t*)(ws + OFF_VCT);
    bf16_t* MIX = (bf16_t*)(ws + OFF_MIX);
    const int tid = tid_o, wid = tid >> 6, lane = tid & 63;
    const int cW = gdim_o * 8 > 1024 ? gdim_o * 8 - 1024 : gdim_o * 8, cw0 = gdim_o * 8 > 1024 ? bid_o * 8 + wid - 1024 : bid_o * 8 + wid;
    for (int idx = cw0 >= 0 ? cw0 * 64 + lane : 1536 * 64; idx < 1536 * 64; idx += cW * 64) {
        const int rg = idx >> 6, cg8 = idx & 63; const int row0 = rg * 8, j0 = cg8 * 8;
        const int smask = row0 < MP ? 255 : 2047;
        float w0[8], w1[8], w2[8];
        { const f32x4 a = *(const f32x4*)(p.short_conv_w + j0), b = *(const f32x4*)(p.short_conv_w + j0 + 4); w0[0] = a[0]; w0[1] = a[1]; w0[2] = a[2]; w0[3] = a[3]; w0[4] = b[0]; w0[5] = b[1]; w0[6] = b[2]; w0[7] = b[3]; }
        { const f32x4 a = *(const f32x4*)(p.short_conv_w + 512 + j0), b = *(const f32x4*)(p.short_conv_w + 512 + j0 + 4); w1[0] = a[0]; w1[1] = a[1]; w1[2] = a[2]; w1[3] = a[3]; w1[4] = b[0]; w1[5] = b[1]; w1[6] = b[2]; w1[7] = b[3]; }
        { const f32x4 a = *(const f32x4*)(p.short_conv_w + 1024 + j0), b = *(const f32x4*)(p.short_conv_w + 1024 + j0 + 4); w2[0] = a[0]; w2[1] = a[1]; w2[2] = a[2]; w2[3] = a[3]; w2[4] = b[0]; w2[5] = b[1]; w2[6] = b[2]; w2[7] = b[3]; }
        u32x4 cw[10], hw[10], bw[8];
        const u32x4 z4 = {0u, 0u, 0u, 0u};
#pragma unroll
        for (int i = 0; i < 10; ++i) { const int r = row0 - 1 + i;
            const bool ok = (i == 0) ? ((row0 & smask) != 0) : (i == 9 ? (((row0 + 8) & smask) != 0) : true);
            if (ok) { cw[i] = __builtin_nontemporal_load((const u32x4*)(BCH + (size_t)r * 1536 + 512 + j0)); hw[i] = __builtin_nontemporal_load((const u32x4*)(BCH + (size_t)r * 1536 + 1024 + j0)); } else { cw[i] = z4; hw[i] = z4; } }
#pragma unroll
        for (int i = 0; i < 8; ++i) bw[i] = __builtin_nontemporal_load((const u32x4*)(BCH + (size_t)(row0 + i) * 1536 + j0));
        float pv[8], cv[8], nv[8];
        { float a[8], b[8]; unpack8(cw[0], a); unpack8(hw[0], b);
#pragma unroll
          for (int j = 0; j < 8; ++j) pv[j] = a[j] * b[j];
          unpack8(cw[1], a); unpack8(hw[1], b);
#pragma unroll
          for (int j = 0; j < 8; ++j) cv[j] = a[j] * b[j]; }
#pragma unroll
        for (int i = 0; i < 8; ++i) {
            float a[8], b[8], o[8]; unpack8(cw[i + 2], a); unpack8(hw[i + 2], b);
#pragma unroll
            for (int j = 0; j < 8; ++j) nv[j] = a[j] * b[j];
            unpack8(bw[i], a);
#pragma unroll
            for (int j = 0; j < 8; ++j) { o[j] = a[j] * (w0[j] * pv[j] + w1[j] * cv[j] + w2[j] * nv[j]); pv[j] = cv[j]; cv[j] = nv[j]; }
            st16(MIX + (size_t)(row0 + i) * DM + 512 + j0, pack8(o));
        }
    }
    const int h = lane >> 5, r = lane & 31;
    const int W = gdim_o * 8, gw = bid_o * 8 + wid;
    const float C1 = 0.125f * 1.4426950408889634f;
    for (int unit = gw; unit < 3072; unit += W) {
        const bool samp = unit < 2048;
        int b, head, q0, row0, nband, clo; const bf16_t* kbase; const bf16_t* vbase;
        if (samp) { b = unit >> 9; head = (unit >> 6) & 7; q0 = (unit & 63) * 32; row0 = MP + b * 2048 + q0; const int hk = head >> 2;
            kbase = Kb + 524288 + (size_t)((b * 2 + hk) * 64) * 2048; vbase = Vt + 524288 + (size_t)((b * 2 + hk) * 64) * 2048;
            clo = q0 >= 128 ? 0 : (128 - q0) >> 5; int chi = (2144 - q0) >> 5; if (chi > 8) chi = 8; nband = chi - clo + 1; }
        else { const int u2 = unit - 2048; b = u2 >> 6; head = (u2 >> 3) & 7; q0 = (u2 & 7) * 32; row0 = b * 256 + q0; const int hk = head >> 2;
            kbase = Kb + (size_t)((b * 2 + hk) * 8) * 2048; vbase = Vt + (size_t)((b * 2 + hk) * 8) * 2048; clo = 0; nband = 8; }
        const int hk = head >> 2;
        const bf16_t* kcb = Kc + (size_t)((b * 2 + hk) * 16) * 2048; const bf16_t* vcb = Vct + (size_t)((b * 2 + hk) * 16) * 2048;
        const int nch = samp ? nband + 16 : nband;
        bf16x8 qf[4];
#pragma unroll
        for (int s = 0; s < 4; ++s) qf[s] = *(const bf16x8*)(Q + (size_t)(row0 + r) * 512 + head * 64 + 16 * s + 8 * h);
        float mrun = p.sink_logit[head] * 1.4426950408889634f, lrun = 1.0f;
        f32x16 O0, O1;
#pragma unroll
        for (int i = 0; i < 16; ++i) { O0[i] = 0.f; O1[i] = 0.f; }
        const bf16_t* kp; const bf16_t* vp; int mk;
#define CHUNK_PTRS(it) do { if ((it) < nband) { const int cc_ = clo + (it); const int ci_ = samp ? ((q0 - 128) >> 5) + cc_ : cc_; kp = kbase + (size_t)ci_ * 2048; vp = vbase + (size_t)ci_ * 2048; \
            mk = samp ? (cc_ == 0 ? 1 : (cc_ == 8 ? 2 : 0)) : 0; } else { const int ci_ = (it) - nband; kp = kcb + (size_t)ci_ * 2048; vp = vcb + (size_t)ci_ * 2048; mk = 0; } } while (0)
        bf16x8 kn[4], vn[4];
        CHUNK_PTRS(0);
#pragma unroll
        for (int s = 0; s < 4; ++s) { kn[s] = *(const bf16x8*)(kp + (s * 64 + lane) * 8); vn[s] = *(const bf16x8*)(vp + (s * 64 + lane) * 8); }
        for (int it = 0; it < nch; ++it) {
            CHUNK_PTRS(it);
            const int mkc = mk;
            bf16x8 kf[4], vf[4];
#pragma unroll
            for (int s = 0; s < 4; ++s) { kf[s] = kn[s]; vf[s] = vn[s]; }
            if (it + 1 < nch) { CHUNK_PTRS(it + 1);
#pragma unroll
                for (int s = 0; s < 4; ++s) { kn[s] = *(const bf16x8*)(kp + (s * 64 + lane) * 8); vn[s] = *(const bf16x8*)(vp + (s * 64 + lane) * 8); } }
            f32x16 sa, sb;
#pragma unroll
            for (int i = 0; i < 16; ++i) { sa[i] = 0.f; sb[i] = 0.f; }
            sa = MFMA32(kf[0], qf[0], sa); sb = MFMA32(kf[1], qf[1], sb);
            sa = MFMA32(kf[2], qf[2], sa); sb = MFMA32(kf[3], qf[3], sb);
            sa += sb;
            float tv[16]; float cm = -1e30f;
            if (mkc != 0) {
#pragma unroll
                for (int i = 0; i < 16; ++i) { const int koff = (i & 3) + 8 * (i >> 2) + 4 * h;
                    const bool ok = (mkc == 1) ? (koff >= r) : (koff <= r);
                    sa[i] = ok ? sa[i] : -1e30f; }
            }
#pragma unroll
            for (int i = 0; i < 16; ++i) cm = fmaxf(cm, sa[i]);
            cm = xmax32(cm) * C1;
            const float mnew = fmaxf(mrun, cm);
            const float alpha = __builtin_amdgcn_exp2f(mrun - mnew);
            float ps = 0.f;
#pragma unroll
            for (int i = 0; i < 16; ++i) { tv[i] = __builtin_amdgcn_exp2f(__builtin_fmaf(sa[i], C1, -mnew)); ps += tv[i]; }
            ps = xsum32(ps);
            lrun = lrun * alpha + ps; mrun = mnew;
            if (__builtin_amdgcn_ballot_w64(alpha != 1.0f) != 0ull) {
#pragma unroll
                for (int i = 0; i < 16; ++i) { O0[i] *= alpha; O1[i] *= alpha; } }
#pragma unroll
            for (int ks = 0; ks < 2; ++ks) { u32x4 w; w.x = pk2(tv[8 * ks + 0], tv[8 * ks + 1]); w.y = pk2(tv[8 * ks + 2], tv[8 * ks + 3]); w.z = pk2(tv[8 * ks + 4], tv[8 * ks + 5]); w.w = pk2(tv[8 * ks + 6], tv[8 * ks + 7]);
                const bf16x8 pb = __builtin_bit_cast(bf16x8, w);
                O0 = MFMA32(vf[ks], pb, O0); O1 = MFMA32(vf[2 + ks], pb, O1); }
        }
#undef CHUNK_PTRS
        const float inv = 1.0f / lrun;
        bf16_t* op = MIX + (size_t)(row0 + r) * DM + head * 64 + 4 * h;
#pragma unroll
        for (int j = 0; j < 4; ++j) { u32x2 w; w.x = pk2(O0[4 * j] * inv, O0[4 * j + 1] * inv); w.y = pk2(O0[4 * j + 2] * inv, O0[4 * j + 3] * inv); st8(op + 8 * j, w);
            u32x2 w2; w2.x = pk2(O1[4 * j] * inv, O1[4 * j + 1] * inv); w2.y = pk2(O1[4 * j + 2] * inv, O1[4 * j + 3] * inv); st8(op + 32 + 8 * j, w2); }
    }
}

DI void spatial_phase(const Params& p, LAS unsigned char* lds) {
    OPAQUE_IDS();
    unsigned char* ws = p.wsp();
    const bf16_t* UG = (const bf16_t*)(ws + OFF_UG); const bf16_t* V1 = (const bf16_t*)(ws + OFF_V1); const bf16_t* WS = (const bf16_t*)(ws + OFF_WSP);
    const float* rss = (const float*)(ws + OFF_RSS); bf16_t* MIX = (bf16_t*)(ws + OFF_MIX);
    LAS bf16_t* VT = (LAS bf16_t*)lds;
    LAS float* RS = (LAS float*)(lds + 128 * 136 * 2);
    const int tid = tid_o, wid = tid >> 6, lane = tid & 63, h = lane >> 5, r = lane & 31;
    const int tb = wid >> 1, chh = wid & 1;
    for (int task = bid_o; task < 768; task += gdim_o) {
        const int chunk = task >> 3, g = task & 7; const int rowb = chunk * 128;
#pragma unroll
        for (int i = 0; i < 4; ++i) { const int e = tid + NT * i; const int s = e >> 4, c8 = e & 15;
            const u32x4 w = __builtin_nontemporal_load((const u32x4*)(V1 + (size_t)(rowb + s) * 1024 + g * 128 + c8 * 8)); *(LAS u32x4*)(VT + s * 136 + c8 * 8) = w; }
        if (tid < 128) RS[tid] = rsqrtf(rss[rowb + tid] * (1.0f / 1024.0f) + 1e-6f);
        const int t0 = tb * 32, c0 = chh * 64;
        u32x4 wpre[8];
#pragma unroll
        for (int kk = 0; kk < 8; ++kk) wpre[kk] = *(const u32x4*)(WS + (size_t)(g * 128 + t0 + r) * 128 + 16 * kk + 8 * h);
        bf16_t upre[2][16];
#pragma unroll
        for (int i = 0; i < 16; ++i) { const int t = t0 + (i & 3) + 8 * (i >> 2) + 4 * h; const size_t o = (size_t)(rowb + t) * 1024 + g * 128 + c0 + r; upre[0][i] = UG[o]; upre[1][i] = UG[o + 32]; }
        __syncthreads();
        f32x16 a0, a1;
#pragma unroll
        for (int i = 0; i < 16; ++i) { a0[i] = 0.f; a1[i] = 0.f; }
#pragma unroll
        for (int kk = 0; kk < 8; ++kk) {
            const int s0 = 16 * kk + 8 * h;
            const u32x4 wa = wpre[kk];
            float fa[8]; unpack8(wa, fa);
            const f32x4 r0 = *(const LAS f32x4*)(RS + s0), r1 = *(const LAS f32x4*)(RS + s0 + 4);
            fa[0] *= r0[0]; fa[1] *= r0[1]; fa[2] *= r0[2]; fa[3] *= r0[3]; fa[4] *= r1[0]; fa[5] *= r1[1]; fa[6] *= r1[2]; fa[7] *= r1[3];
            const bf16x8 af = __builtin_bit_cast(bf16x8, pack8(fa));
            bf16x8 b0, b1;
#pragma unroll
            for (int j = 0; j < 8; ++j) { b0[j] = (short)VT[(s0 + j) * 136 + c0 + r]; b1[j] = (short)VT[(s0 + j) * 136 + c0 + 32 + r]; }
            a0 = MFMA32(af, b0, a0); a1 = MFMA32(af, b1, a1);
        }
        const float vg0 = p.gmlp_norm_g[g * 128 + c0 + r], vg1 = p.gmlp_norm_g[g * 128 + c0 + 32 + r];
#pragma unroll
        for (int i = 0; i < 16; ++i) { const int t = t0 + (i & 3) + 8 * (i >> 2) + 4 * h; const float bs = p.b_spatial[g * 128 + t];
            const size_t o = (size_t)(rowb + t) * 1024 + g * 128 + c0 + r;
            const float u0 = bflo((unsigned)upre[0][i]), u1 = bflo((unsigned)upre[1][i]);
            MIX[o] = f2bf(u0 * (a0[i] * vg0 + bs)); MIX[o + 32] = f2bf(u1 * (a1[i] * vg1 + bs)); }
        __syncthreads();
    }
}

DI void edge_fixup(const bf16_t* EDGE, bf16_t* ACT, const float* cw  , int pm) {
    OPAQUE_IDS();
    (void)bid_o; (void)gdim_o;
    for (int idx = tid_o; idx < 2 * 352; idx += NT) {
        const int half = idx / 352, cgp = idx - half * 352, j0 = cgp * 8;
        f32x4 a[3][2], b[3][2];
#pragma unroll
        for (int tp = 0; tp < 3; ++tp)
#pragma unroll
            for (int hh = 0; hh < 2; ++hh) { a[tp][hh] = *(const f32x4*)(cw + tp * 5632 + j0 + 4 * hh); b[tp][hh] = *(const f32x4*)(cw + tp * 5632 + 2816 + j0 + 4 * hh); }
        u32x4 gw[4][3], vw[4][3];
        const u32x4 z4 = {0u, 0u, 0u, 0u};
#pragma unroll
        for (int q = 0; q < 4; ++q) {
            const int er = half * 4 + q;
            const int band = pm * 4 + (er >> 1), last = er & 1, row = band * 64 + (last ? 63 : 0);
            const int smask = row < MP ? 255 : 2047;
            const bf16_t *pp, *pc, *pn; bool okp = true, okn = true;
            if (!last) { pc = EDGE + (size_t)(band * 4 + 0) * 5632; pn = EDGE + (size_t)(band * 4 + 1) * 5632; okp = (row & smask) != 0; pp = EDGE + (size_t)((okp ? band - 1 : band) * 4 + 3) * 5632; }
            else { pp = EDGE + (size_t)(band * 4 + 2) * 5632; pc = EDGE + (size_t)(band * 4 + 3) * 5632; okn = ((row + 1) & smask) != 0; pn = EDGE + (size_t)((okn ? band + 1 : band) * 4 + 0) * 5632; }
            gw[q][0] = okp ? *(const u32x4*)(pp + j0) : z4; vw[q][0] = okp ? *(const u32x4*)(pp + 2816 + j0) : z4;
            gw[q][1] = *(const u32x4*)(pc + j0); vw[q][1] = *(const u32x4*)(pc + 2816 + j0);
            gw[q][2] = okn ? *(const u32x4*)(pn + j0) : z4; vw[q][2] = okn ? *(const u32x4*)(pn + 2816 + j0) : z4;
        }
#pragma unroll
        for (int q = 0; q < 4; ++q) {
            const int er = half * 4 + q;
            const int row = (pm * 4 + (er >> 1)) * 64 + ((er & 1) ? 63 : 0);
            float gp[8], gc[8], gn[8], vp[8], vc[8], vn[8], o[8];
            unpack8(gw[q][0], gp); unpack8(gw[q][1], gc); unpack8(gw[q][2], gn); unpack8(vw[q][0], vp); unpack8(vw[q][1], vc); unpack8(vw[q][2], vn);
#pragma unroll
            for (int hh = 0; hh < 2; ++hh)
#pragma unroll
                for (int e = 0; e < 4; ++e) { const int j = 4 * hh + e;
                    const float g = a[0][hh][e] * gp[j] + a[1][hh][e] * gc[j] + a[2][hh][e] * gn[j]; const float v = b[0][hh][e] * vp[j] + b[1][hh][e] * vc[j] + b[2][hh][e] * vn[j];
                    o[j] = silu_f(g) * v; }
            *(u32x4*)(ACT + (size_t)row * 2816 + j0) = pack8(o);
        }
    }
    asm volatile("s_waitcnt vmcnt(0)" ::: "memory");
    __syncthreads();
}

#define XB_TMO      128
#define XB_XCNT(j)  (256  + 64 * (j))
#define XB_XSUB(j)  (1280 + 64 * (j))
#define XB_XGEN(j)  (2304 + 64 * (j))
#define XB_TOP      3328
#define XB_TOPGEN   3392
#define XCD_BAR_WORDS 3456
#define XB_SPIN_CAP (1u << 20)
DI unsigned xb_ld(unsigned* p)              { return __hip_atomic_load(p, __ATOMIC_RELAXED, __HIP_MEMORY_SCOPE_AGENT); }
DI unsigned xb_add(unsigned* p, unsigned v) { return __hip_atomic_fetch_add(p, v, __ATOMIC_RELAXED, __HIP_MEMORY_SCOPE_AGENT); }
DI unsigned xb_xcc_id() { return (unsigned)__builtin_amdgcn_s_getreg((3 << 11) | 20) & 0xFu; }
#define XB_SPIN(cond, bar) do { unsigned _sp = 0; while (cond) { __builtin_amdgcn_s_sleep(1); \
    if ((++_sp & 255u) == 0u) { if (xb_ld(&(bar)[XB_TMO])) break; if (_sp > XB_SPIN_CAP) { atomicAdd(&(bar)[XB_TMO], 1u); break; } } } } while (0)
DI void xcd_barrier_complete(unsigned* bar, unsigned x, unsigned G, unsigned& nloc, unsigned& nx) {
    unsigned sum, cnt, mine, sp = 0u;
    for (;;) {
        sum = 0u; cnt = 0u; mine = 0u;
#pragma unroll
        for (unsigned j = 0; j < 16; ++j) { const unsigned c = xb_ld(&bar[XB_XCNT(j)]); sum += c; cnt += (c > 0u) ? 1u : 0u; mine = (j == x) ? c : mine; }
        if (sum == G) break;
        __builtin_amdgcn_s_sleep(1);
        if ((++sp & 255u) == 0u) { if (xb_ld(&bar[XB_TMO])) break; if (sp > XB_SPIN_CAP) { atomicAdd(&bar[XB_TMO], 1u); break; } }
    }
    nloc = mine > 0u ? mine : 1u; nx = cnt > 0u ? cnt : 1u;
}
DI void xcd_barrier(unsigned* bar, volatile LAS unsigned* st) {
    asm volatile("s_waitcnt vmcnt(0)" ::: "memory");
    __syncthreads();
    if (threadIdx.x == 0) {
        const unsigned x = xb_xcc_id();
        __builtin_amdgcn_s_waitcnt(0);
        unsigned nloc = st[0], nx = st[1];
        if (nloc == 0u) { xcd_barrier_complete(bar, x, gridDim.x, nloc, nx); st[0] = nloc; st[1] = nx; }
        const unsigned old = xb_add(&bar[XB_XSUB(x)], 1u);
        const unsigned gen = old / nloc;
        if (old + 1u == (gen + 1u) * nloc) {
            __builtin_amdgcn_fence(__ATOMIC_RELEASE, "agent");
            asm volatile("s_waitcnt vmcnt(0)" ::: "memory");
            const unsigned og = xb_add(&bar[XB_TOP], 1u);
            const unsigned tg = og / nx;
            if (og + 1u == (tg + 1u) * nx) xb_add(&bar[XB_TOPGEN], 1u);
            else XB_SPIN(xb_ld(&bar[XB_TOPGEN]) == tg, bar);
            __builtin_amdgcn_fence(__ATOMIC_ACQUIRE, "agent");
            xb_add(&bar[XB_XGEN(x)], 1u);
            asm volatile("s_waitcnt vmcnt(0)" ::: "memory");
        } else {
            XB_SPIN(xb_ld(&bar[XB_XGEN(x)]) == gen, bar);
            __builtin_amdgcn_fence(__ATOMIC_ACQUIRE, "agent");
            asm volatile("s_waitcnt vmcnt(0)" ::: "memory");
        }
    }
    __syncthreads();
}

__global__ void __launch_bounds__(NT, 2) mega(KArgs ka) {
    extern __shared__ __attribute__((aligned(16))) unsigned char lds_raw[];
    LAS unsigned char* lds = (LAS unsigned char*)lds_raw;
    cg::grid_group grid = cg::this_grid();
    Params p; p.tab = (LAS unsigned long long*)(lds + PTAB_OFF);
    volatile LAS unsigned* bst = (volatile LAS unsigned*)(lds + PTAB_OFF + 240);
    if (threadIdx.x == 0) {
#pragma unroll
        for (int i = 0; i < 24; ++i) p.tab[i] = (unsigned long long)ka.in[i];
        p.tab[24] = (unsigned long long)ka.out; p.tab[25] = (unsigned long long)ka.ws;
        bst[0] = 0u; bst[1] = 0u;
        (void)xb_add(&((unsigned*)(ka.ws + OFF_BAR))[XB_XCNT(xb_xcc_id())], 1u);
    }
    __syncthreads();
    const int lo = ka.ph_lo, hi = ka.ph_hi;
#define IN(k) (lo <= (k) && (k) < hi)
    if (ka.ph_hi > 1000) grid.sync();
#define SEAM(k) do { if (IN(k) && IN((k) + 1)) xcd_barrier((unsigned*)(p.wsp() + OFF_BAR), bst); } while (0)

    if (IN(0)) for (int rep = 0; rep < REPS(0); ++rep) phase0(p, lds);
    SEAM(0);
    for (int layer = 0; layer < 2; ++layer) {
        if (layer == 0) {
            if (IN(1)) { unsigned char* ws = p.wsp();
                for (int rep = 0; rep < REPS(1); ++rep) modulate_phase(p.x_prompt, p.x_sample, p.norm_mix_g, (const float*)(ws + OFF_MOD), 0, (bf16_t*)(ws + OFF_H));
                tables_phase(p); }
            SEAM(1);
            if (IN(2)) { unsigned char* ws = p.wsp(); float* xo = p.outp();
                Gemm g{(const bf16_t*)(ws + OFF_H), (const bf16_t*)(ws + OFF_WT_IN_EVEN), MROWS, 2304, 1024};
                EpiInEven E{(bf16_t*)(ws + OFF_Q), (bf16_t*)(ws + OFF_KB), (bf16_t*)(ws + OFF_VT), (bf16_t*)(ws + OFF_BCH),
                            xo + (size_t)MROWS * DM, xo + (size_t)MROWS * DM + 524288, p.q_norm_g, p.k_norm_g, (const f32x2*)(ws + OFF_ROPE)};
                for (int rep = 0; rep < REPS(2); ++rep) gemm_phase(lds, g, E);
                bg_run(p, lds, 0);
            }
            SEAM(2);
            if (IN(3)) for (int rep = 0; rep < REPS(3); ++rep) attn_phase(p);
            SEAM(3);
        } else {
            if (IN(7)) { unsigned char* ws = p.wsp();
                Gemm g{(const bf16_t*)(ws + OFF_H), (const bf16_t*)(ws + OFF_WT_IN_ODD), MROWS, 2048, 1024};
                EpiInOdd E{(bf16_t*)(ws + OFF_UG), (bf16_t*)(ws + OFF_V1), (float*)(ws + OFF_RSS), (const float*)(ws + OFF_RSS) + 2 * MROWS, (const float*)(ws + OFF_SW) + 5 * 5632};
                gemm_phase(lds, g, E);
            }
            SEAM(7);
            if (IN(8)) for (int rep = 0; rep < REPS(11); ++rep) spatial_phase(p, lds);
            SEAM(8);
        }
        const int pb = layer == 0 ? 4 : 9;
        if (IN(pb)) { unsigned char* ws = p.wsp(); float* xo = p.outp();
            Gemm g{(const bf16_t*)(ws + OFF_MIX), (const bf16_t*)(ws + (layer == 0 ? OFF_WT_OUT_EVEN : OFF_WT_OUT_ODD)), MROWS, 1024, 1024};
            EpiResid E{p.x_prompt, p.x_sample, layer == 0 ? (const bf16_t*)nullptr : (const bf16_t*)(ws + OFF_XB), xo, (bf16_t*)(ws + OFF_XB),
                       (const float*)(ws + OFF_MOD) + (size_t)layer * 5 * 6144 + 2 * 1024,
                       (bf16_t*)(ws + OFF_H), (const float*)(ws + OFF_GS) + (layer == 0 ? 0 : 2) * 5120, (float*)(ws + OFF_RSS) + (layer == 0 ? 1 : 3) * MROWS};
            gemm_phase(lds, g, E);
            if (layer == 0) bg_run(p, lds, 1);
        }
        SEAM(pb);
        if (IN(pb + 1)) { unsigned char* ws = p.wsp();
            if (layer == 0) gs_l1_phase(p);
            Gemm g{(const bf16_t*)(ws + OFF_H), (const bf16_t*)(ws + OFF_WT_UP + (size_t)layer * SZ_WT_UP), MROWS, 5632, 1024};
            EpiUpConv E{(bf16_t*)(ws + OFF_ACT), (bf16_t*)(ws + OFF_EDGE), p.ffn_conv_w + (size_t)layer * 3 * 5632,
                        (const float*)(ws + OFF_RSS) + (layer == 0 ? 1 : 3) * MROWS, (const float*)(ws + OFF_SW) + (layer == 0 ? 0 : 5 * 7680)};
            gemm_phase(lds, g, E);
            if (layer == 0) bg_run(p, lds, 2);
        }
        SEAM(pb + 1);
        if (IN(pb + 2)) { unsigned char* ws = p.wsp(); float* xo = p.outp();
            { StaticOrder S; S.init(MROWS, 1024, (int)gridDim.x, (int)blockIdx.x); Unit u0;
              for (int i = 0; S.next(i, u0); ++i) edge_fixup((const bf16_t*)(ws + OFF_EDGE), (bf16_t*)(ws + OFF_ACT), p.ffn_conv_w + (size_t)layer * 3 * 5632, u0.pm); }
            Gemm g{(const bf16_t*)(ws + OFF_ACT), (const bf16_t*)(ws + OFF_WT_DOWN + (size_t)layer * SZ_WT_DOWN), MROWS, 1024, 2816};
            EpiResid E{xo, xo, (const bf16_t*)(ws + OFF_XB), xo, layer == 0 ? (bf16_t*)(ws + OFF_XB) : (bf16_t*)nullptr,
                       (const float*)(ws + OFF_MOD) + (size_t)layer * 5 * 6144 + 5 * 1024,
                       layer == 0 ? (bf16_t*)(ws + OFF_H) : (bf16_t*)nullptr, (const float*)(ws + OFF_GS) + 5120, (float*)(ws + OFF_RSS) + 2 * MROWS};
            gemm_phase(lds, g, E);
            if (layer == 0) bg_run(p, lds, 3);
        }
        SEAM(pb + 2);
    }
#undef IN
#undef SEAM
}

constexpr int LDS_TOTAL = LDS_BYTES + 256;
extern "C" void kernel_launch(void* const* d_in, const int* in_sizes, int n_in, void* d_out, int out_size, void* d_ws, size_t ws_size, hipStream_t stream) {
    static int grid = 0;
    if (grid == 0) {
        int dev = 0, cus = 0, per_cu = 0;
        (void)hipGetDevice(&dev);
        (void)hipDeviceGetAttribute(&cus, hipDeviceAttributeMultiprocessorCount, dev);
        if (hipFuncSetAttribute((const void*)mega, hipFuncAttributeMaxDynamicSharedMemorySize, LDS_TOTAL) != hipSuccess) { fprintf(stderr, "hipFuncSetAttribute failed\n"); grid = -1; return; }
        if (hipOccupancyMaxActiveBlocksPerMultiprocessor(&per_cu, (const void*)mega, NT, LDS_TOTAL) != hipSuccess || per_cu < 1) { fprintf(stderr, "occupancy query failed (%d)\n", per_cu); (void)hipGetLastError(); per_cu = 1; }
        if (per_cu > 1) per_cu = 1;
        grid = cus * per_cu;
    }
    if (grid < 0) return;
    KArgs ka{};
    for (int i = 0; i < 24; ++i) ka.in[i] = (const float*)d_in[i];
    ka.out = (float*)d_out; ka.ws = (unsigned char*)d_ws;
    if (hipMemsetAsync((unsigned char*)d_ws + OFF_BAR, 0, BAR_BYTES, stream) != hipSuccess) { fprintf(stderr, "memset failed\n"); return; }
#if COOP
    ka.ph_lo = 0; ka.ph_hi = 12;
    void* args[] = {&ka};
    hipError_t e = hipLaunchCooperativeKernel((const void*)mega, dim3(grid), dim3(NT), args, LDS_TOTAL, stream);
    if (e != hipSuccess) fprintf(stderr, "cooperative launch failed: %s (grid %d)\n", hipGetErrorString(e), grid);
#else
    for (int ph = 0; ph < 12; ++ph) { ka.ph_lo = ph; ka.ph_hi = ph + 1; hipLaunchKernelGGL(mega, dim3(grid), dim3(NT), LDS_TOTAL, stream, ka); }
#endif
}
```

```cpp
#include <hip/hip_runtime.h>
#include <hip/hip_cooperative_groups.h>
#include <cstdio>
namespace cg = cooperative_groups;

#ifndef COOP
#define COOP 1
#endif
#ifndef REPMASK
#define REPMASK 0
#endif
#define REPS(k) (1 + ((REPMASK >> (k)) & 1))

#define LAS __attribute__((address_space(3)))
#define DI __device__ __forceinline__
typedef unsigned short bf16_t;
typedef short bf16x8 __attribute__((ext_vector_type(8)));
typedef float f32x4 __attribute__((ext_vector_type(4)));
typedef float f32x2 __attribute__((ext_vector_type(2)));
typedef float f32x16 __attribute__((ext_vector_type(16)));
typedef unsigned u32x4 __attribute__((ext_vector_type(4)));
typedef unsigned u32x2 __attribute__((ext_vector_type(2)));
typedef __bf16 bf2_t __attribute__((ext_vector_type(2)));

DI unsigned pk2(float a, float b) { f32x2 v = {a, b}; bf2_t r = __builtin_convertvector(v, bf2_t); return __builtin_bit_cast(unsigned, r); }
DI float bflo(unsigned w) { return __uint_as_float(w << 16); }
DI float bfhi(unsigned w) { return __uint_as_float(w & 0xffff0000u); }
DI bf16_t f2bf(float a) { return (bf16_t)(pk2(a, 0.f) & 0xffffu); }
DI void unpack8(const u32x4 w, float (&f)[8]) {
    f[0] = bflo(w.x); f[1] = bfhi(w.x); f[2] = bflo(w.y); f[3] = bfhi(w.y); f[4] = bflo(w.z); f[5] = bfhi(w.z); f[6] = bflo(w.w); f[7] = bfhi(w.w);
}
DI u32x4 pack8(const float (&f)[8]) { u32x4 w; w.x = pk2(f[0], f[1]); w.y = pk2(f[2], f[3]); w.z = pk2(f[4], f[5]); w.w = pk2(f[6], f[7]); return w; }

DI float xsum32(float x) { auto r = __builtin_amdgcn_permlane32_swap(__float_as_uint(x), __float_as_uint(x), false, false); return __uint_as_float(r[0]) + __uint_as_float(r[1]); }
DI float xmax32(float x) { auto r = __builtin_amdgcn_permlane32_swap(__float_as_uint(x), __float_as_uint(x), false, false); return fmaxf(__uint_as_float(r[0]), __uint_as_float(r[1])); }
DI float xsum16(float x) { auto r = __builtin_amdgcn_permlane16_swap(__float_as_uint(x), __float_as_uint(x), false, false); return __uint_as_float(r[0]) + __uint_as_float(r[1]); }
DI float wave_sum(float x) {
    x += __int_as_float(__builtin_amdgcn_update_dpp(0, __float_as_int(x), 0x128, 0xf, 0xf, false));
    x += __int_as_float(__builtin_amdgcn_update_dpp(0, __float_as_int(x), 0x124, 0xf, 0xf, false));
    x += __int_as_float(__builtin_amdgcn_update_dpp(0, __float_as_int(x), 0x122, 0xf, 0xf, false));
    x += __int_as_float(__builtin_amdgcn_update_dpp(0, __float_as_int(x), 0x121, 0xf, 0xf, false));
    return xsum32(xsum16(x));
}
#ifndef WT_STORES
#define WT_STORES 0
#endif
DI void st8(void* p, u32x2 v) {
#if WT_STORES
    __hip_atomic_store((unsigned long long*)p, ((unsigned long long)v.y << 32) | v.x, __ATOMIC_RELAXED, __HIP_MEMORY_SCOPE_AGENT);
#else
    *(u32x2*)p = v;
#endif
}
DI void st16(void* p, u32x4 v) {
#if WT_STORES
    u32x2 a = {v.x, v.y}, b = {v.z, v.w}; st8(p, a); st8((char*)p + 8, b);
#else
    *(u32x4*)p = v;
#endif
}
DI void st16f(void* p, f32x4 v) { u32x4 w = {__float_as_uint(v[0]), __float_as_uint(v[1]), __float_as_uint(v[2]), __float_as_uint(v[3])}; st16(p, w); }
#define OPAQUE_IDS() int tid_o = threadIdx.x; asm volatile("" : "+v"(tid_o)); int bid_o = blockIdx.x; asm volatile("" : "+s"(bid_o)); int gdim_o = gridDim.x; asm volatile("" : "+s"(gdim_o))
constexpr int MROWS = 12288, DM = 1024, MP = 4096;
constexpr int NT = 512;
constexpr int LDS_BYTES = 131072;
constexpr size_t OFF_WT_IN_EVEN = 0;
constexpr size_t OFF_WT_OUT_EVEN = OFF_WT_IN_EVEN + 2304ull * 1024 * 2;
constexpr size_t OFF_WT_IN_ODD = OFF_WT_OUT_EVEN + 1024ull * 1024 * 2;
constexpr size_t OFF_WT_OUT_ODD = OFF_WT_IN_ODD + 2048ull * 1024 * 2;
constexpr size_t OFF_WT_UP = OFF_WT_OUT_ODD + 1024ull * 1024 * 2;
constexpr size_t SZ_WT_UP = 5632ull * 1024 * 2;
constexpr size_t OFF_WT_DOWN = OFF_WT_UP + 2 * SZ_WT_UP;
constexpr size_t SZ_WT_DOWN = 1024ull * 2816 * 2;
constexpr size_t OFF_WSP = OFF_WT_DOWN + 2 * SZ_WT_DOWN;
constexpr size_t OFF_KC = OFF_WSP + 8ull * 128 * 128 * 2;
constexpr size_t OFF_VCT = OFF_KC + 4ull * 512 * 128 * 2;
constexpr size_t OFF_ROPE = OFF_VCT + 4ull * 512 * 128 * 2;
constexpr size_t OFF_MOD = OFF_ROPE + 64ull * 16 * 8;
constexpr size_t OFF_RSS = OFF_MOD + 2ull * 5 * 6144 * 4;
constexpr size_t OFF_GS = OFF_RSS + 4ull * 12288 * 4;
constexpr size_t OFF_SW = OFF_GS + 3ull * 5 * 1024 * 4;
constexpr size_t OFF_BAR = ((OFF_SW + 5ull * 13312 * 4 + 4095) / 4096) * 4096;
constexpr size_t BAR_BYTES = 16384;
constexpr size_t OFF_ACT = OFF_BAR + BAR_BYTES;
constexpr size_t OFF_U = OFF_ACT + (size_t)MROWS * 2816 * 2;
constexpr size_t OFF_Q = OFF_U;
constexpr size_t OFF_KB = OFF_Q + (size_t)MROWS * 512 * 2;
constexpr size_t OFF_VT = OFF_KB + (size_t)MROWS * 128 * 2;
constexpr size_t OFF_BCH = OFF_VT + (size_t)MROWS * 128 * 2;
constexpr size_t OFF_MIX = OFF_BCH + (size_t)MROWS * 1536 * 2;
constexpr size_t OFF_UG = OFF_U;
constexpr size_t OFF_V1 = OFF_UG + (size_t)MROWS * 1024 * 2;
constexpr size_t OFF_EDGE = OFF_U;
constexpr size_t OFF_H = OFF_U + 84ull * 1024 * 1024;
constexpr size_t OFF_XB = OFF_U + 109ull * 1024 * 1024;
static_assert(OFF_MIX + (size_t)MROWS * 1024 * 2 <= OFF_H && OFF_H + (size_t)MROWS * 1024 * 2 <= OFF_XB && OFF_XB + (size_t)MROWS * 1024 * 2 <= 256ull * 1024 * 1024, "layout");
static_assert(OFF_V1 + (size_t)MROWS * 1024 * 2 <= OFF_MIX, "layout");


struct KArgs { const float* in[24]; float* out; unsigned char* ws; int ph_lo, ph_hi; };
constexpr int PTAB_OFF = LDS_BYTES;
struct Params {
    LAS unsigned long long* tab;
    DI unsigned long long raw(int i) const { const unsigned long long v = tab[i]; const unsigned lo = __builtin_amdgcn_readfirstlane((unsigned)v), hi = __builtin_amdgcn_readfirstlane((unsigned)(v >> 32)); return ((unsigned long long)hi << 32) | lo; }
    DI const float* in(int i) const { return (const float*)(const __attribute__((address_space(1))) float*)raw(i); }
    DI float* outp() const { return (float*)(__attribute__((address_space(1))) float*)raw(24); }
    DI unsigned char* wsp() const { return (unsigned char*)(__attribute__((address_space(1))) unsigned char*)raw(25); }
};
#define x_prompt in(0)
#define x_sample in(1)
#define cache_k in(2)
#define cache_v in(3)
#define c_lat in(4)
#define c_ctx in(5)
#define ada_w in(6)
#define ada_b in(7)
#define norm_mix_g in(8)
#define norm_ffn_g in(9)
#define w_in_even in(10)
#define q_norm_g in(11)
#define k_norm_g in(12)
#define sink_logit in(13)
#define short_conv_w in(14)
#define w_out_even in(15)
#define w_in_odd in(16)
#define gmlp_norm_g in(17)
#define w_spatial in(18)
#define b_spatial in(19)
#define w_out_odd in(20)
#define w_up in(21)
#define ffn_conv_w in(22)
#define w_down in(23)

constexpr int BM = 256, BK = 64, HALF = 128, HTB = HALF * BK * 2, NXCD = 8, WGM = 8;
DI int lds_byte(int r, int c) { const int st = (r >> 4) * 2 + (c >> 5), rr = r & 15, cc = c & 31, ob = rr * 64 + cc * 2; return st * 1024 + (ob ^ (((ob >> 9) & 1) << 5)); }
DI void stage_rc(int b, int& R, int& C) { const int st = b / 1024, sb = b % 1024, swz = sb ^ (((sb >> 9) & 1) << 5); R = (st >> 1) * 16 + swz / 64; C = (st & 1) * 32 + (swz % 64) / 2; }
DI int perm32(int rho) { const int n = rho >> 4, i = rho & 15; return 8 * (i >> 2) + 4 * n + (i & 3); }
struct Unit { int pm, pn; };
struct Gemm { const bf16_t* A; const bf16_t* Bt; int M, N, K; };
struct StaticOrder {
    int nM, nN, nwg, G, c;
    DI void init(int M, int N, int G_, int c_) { nM = M / BM; nN = N / BM; nwg = nM * nN; G = G_; c = c_; }
    DI bool next(int i, Unit& u) const {
        const long L = (long)i * G + c; if (L >= nwg) return false;
        int wgid = (int)L; { const int q = nwg / NXCD, r = nwg % NXCD, xcd = wgid % NXCD, off = wgid / NXCD; wgid = (xcd < r ? xcd * (q + 1) : r * (q + 1) + (xcd - r) * q) + off; }
        const int nig = WGM * nN, gid = wgid / nig, fm = gid * WGM, gsz = (nM - fm) < WGM ? (nM - fm) : WGM;
        u.pm = fm + ((wgid % nig) % gsz); u.pn = (wgid % nig) / gsz; return true;
    }
};

template <class Epi>
DI void gemm_phase(LAS unsigned char* lds, const Gemm g, const Epi& E) {
    OPAQUE_IDS();
    const int tid = tid_o, wid = __builtin_amdgcn_readfirstlane(tid >> 6), lane = tid & 63, wr = wid >> 2, wc = wid & 3, fr = lane & 15, fq = lane >> 4;
    const int K = g.K, nt = K / BK;
    StaticOrder S; S.init(g.M, g.N, gdim_o, bid_o);
    unsigned voffA[2], voffB[2];
#pragma unroll
    for (int i = 0; i < 2; ++i) { int R, C; stage_rc(tid * 16 + i * 8192, R, C); const int Rb = Epi::PERM ? ((R & ~31) + perm32(R & 31)) : R;
        voffA[i] = (unsigned)(R * K + C) * 2u; voffB[i] = (unsigned)(Rb * K + C) * 2u; }
    const size_t kstep = (size_t)(BK * 2);
    const size_t hstep = (size_t)HALF * K * 2;
    const size_t tstep = 2 * hstep;
    const unsigned ldsw = (unsigned)wid * 1024u;
    const int aoff = lds_byte(wr * 64 + fr, fq * 8), boff = lds_byte(wc * 32 + fr, fq * 8);
#define PG8_SA(b, h) (((b) * 2 + (h)) * HTB)
#define PG8_SB(b, h) ((4 + (b) * 2 + (h)) * HTB)
#define PG8_STAGE(bufoff, gbase, voff) do { _Pragma("unroll") for (int _i = 0; _i < 2; ++_i) \
        __builtin_amdgcn_global_load_lds((const unsigned*)((const char*)(gbase) + (voff)[_i]), (LAS unsigned*)(lds + (bufoff) + ldsw + _i * 8192), 16, 0, 0); } while (0)
#define PG8_LDA(dst, b, h) do { _Pragma("unroll") for (int m = 0; m < 4; ++m) _Pragma("unroll") for (int k = 0; k < 2; ++k) dst[m][k] = *(const LAS bf16x8*)(lds + PG8_SA(b, h) + aoff + m * 2048 + k * 1024); } while (0)
#define PG8_LDB(dst, b, h) do { _Pragma("unroll") for (int n = 0; n < 2; ++n) _Pragma("unroll") for (int k = 0; k < 2; ++k) dst[n][k] = *(const LAS bf16x8*)(lds + PG8_SB(b, h) + boff + n * 2048 + k * 1024); } while (0)
#define PG8_MMA(ai, bj, At, Bt) do { __builtin_amdgcn_s_setprio(1); _Pragma("unroll") for (int m = 0; m < 4; ++m) _Pragma("unroll") for (int n = 0; n < 2; ++n) _Pragma("unroll") for (int k = 0; k < 2; ++k) \
        acc[ai][bj][m][n] = __builtin_amdgcn_mfma_f32_16x16x32_bf16(Bt[n][k], At[m][k], acc[ai][bj][m][n], 0, 0, 0); __builtin_amdgcn_s_setprio(0); } while (0)
#define PG8_WAIT_V(n) asm volatile("s_waitcnt vmcnt(" #n ")" ::: "memory")
#define PG8_WAIT_L(n) asm volatile("s_waitcnt lgkmcnt(" #n ")" ::: "memory")
#define PG8_BAR __builtin_amdgcn_s_barrier()
#define PG8_SCHED __builtin_amdgcn_sched_barrier(0)
    Unit cur, nxt; int ui = 0;
    if (!S.next(0, cur)) return;
    f32x4 acc[2][2][4][2];
#pragma unroll
    for (int a = 0; a < 2; ++a)
#pragma unroll
        for (int b = 0; b < 2; ++b)
#pragma unroll
            for (int m = 0; m < 4; ++m)
#pragma unroll
                for (int n = 0; n < 2; ++n) acc[a][b][m][n] = (f32x4){0.f, 0.f, 0.f, 0.f};
    bf16x8 At[4][2], B0[2][2], B1[2][2];
    const char* cA = (const char*)g.A + (size_t)cur.pm * tstep; const char* cB = (const char*)g.Bt + (size_t)cur.pn * tstep;
    PG8_STAGE(PG8_SB(0, 0), cB, voffB); PG8_STAGE(PG8_SA(0, 0), cA, voffA); PG8_STAGE(PG8_SB(0, 1), cB + hstep, voffB); PG8_STAGE(PG8_SA(0, 1), cA + hstep, voffA);
    if (wr == 1) PG8_BAR;
    PG8_WAIT_V(4); PG8_BAR;
    PG8_STAGE(PG8_SB(1, 0), cB + kstep, voffB); PG8_STAGE(PG8_SA(1, 0), cA + kstep, voffA); PG8_STAGE(PG8_SB(1, 1), cB + hstep + kstep, voffB);
    PG8_WAIT_V(6); PG8_BAR;
    for (;;) {
        const bool has_next = S.next(ui + 1, nxt);
        const char* nA = has_next ? (const char*)g.A + (size_t)nxt.pm * tstep : cA; const char* nB = has_next ? (const char*)g.Bt + (size_t)nxt.pn * tstep : cB;
        for (int t = 0; t < nt; t += 2) {
            const bool last = (t == nt - 2);
            const char* a1 = cA + (size_t)(t + 1) * kstep;
            const char* a2 = last ? nA : cA + (size_t)(t + 2) * kstep; const char* b2 = last ? nB : cB + (size_t)(t + 2) * kstep;
            const char* a3 = a2 + kstep; const char* b3 = b2 + kstep;
            PG8_LDB(B0, 0, 0); PG8_SCHED; PG8_LDA(At, 0, 0); PG8_STAGE(PG8_SA(1, 1), a1 + hstep, voffA);
            PG8_WAIT_L(8); PG8_BAR; PG8_WAIT_L(0); PG8_MMA(0, 0, At, B0); PG8_BAR; PG8_SCHED;
            PG8_LDB(B1, 0, 1); PG8_STAGE(PG8_SB(0, 0), b2, voffB);
            PG8_BAR; PG8_WAIT_L(0); PG8_MMA(0, 1, At, B1); PG8_BAR;
            PG8_LDA(At, 0, 1); PG8_STAGE(PG8_SA(0, 0), a2, voffA);
            PG8_BAR; PG8_WAIT_L(0); PG8_MMA(1, 0, At, B0); PG8_BAR; PG8_SCHED;
            PG8_STAGE(PG8_SB(0, 1), b2 + hstep, voffB);
            PG8_WAIT_V(6); PG8_BAR; PG8_MMA(1, 1, At, B1); PG8_BAR;
            PG8_LDB(B0, 1, 0); PG8_SCHED; PG8_LDA(At, 1, 0); PG8_STAGE(PG8_SA(0, 1), a2 + hstep, voffA);
            PG8_WAIT_L(8); PG8_BAR; PG8_WAIT_L(0); PG8_MMA(0, 0, At, B0); PG8_BAR; PG8_SCHED;
            PG8_LDB(B1, 1, 1); PG8_STAGE(PG8_SB(1, 0), b3, voffB);
            PG8_BAR; PG8_WAIT_L(0); PG8_MMA(0, 1, At, B1); PG8_BAR;
            PG8_LDA(At, 1, 1); PG8_STAGE(PG8_SA(1, 0), a3, voffA);
            PG8_BAR; PG8_WAIT_L(0); PG8_MMA(1, 0, At, B0); PG8_BAR; PG8_SCHED;
            PG8_STAGE(PG8_SB(1, 1), b3 + hstep, voffB);
            PG8_WAIT_V(6); PG8_BAR; PG8_MMA(1, 1, At, B1); PG8_BAR;
        }
        E(acc, cur, wr, wc, fr, fq);
        if (!has_next) break;
#pragma unroll
        for (int a = 0; a < 2; ++a)
#pragma unroll
            for (int b = 0; b < 2; ++b)
#pragma unroll
                for (int m = 0; m < 4; ++m)
#pragma unroll
                    for (int n = 0; n < 2; ++n) acc[a][b][m][n] = (f32x4){0.f, 0.f, 0.f, 0.f};
        cur = nxt; cA = nA; cB = nB; ++ui;
    }
    PG8_WAIT_V(0);
    if (wr == 0) PG8_BAR;
    PG8_BAR;
#undef PG8_SA
#undef PG8_SB
#undef PG8_STAGE
#undef PG8_LDA
#undef PG8_LDB
#undef PG8_MMA
#undef PG8_WAIT_V
#undef PG8_WAIT_L
#undef PG8_BAR
#undef PG8_SCHED
}

struct EpiInEven {
    static constexpr bool PERM = false;
    bf16_t *Q, *Kb, *Vt, *BCH; float *outK, *outV; const float *qg, *kg; const f32x2* rope;
    DI void operator()(f32x4 (&acc)[2][2][4][2], const Unit& u, int wr, int wc, int fr_, int fq_) const {
        int fr = fr_, fq = fq_; asm volatile("" : "+v"(fr), "+v"(fq));
        const int row0 = u.pm * BM + wr * 64 + fr;
        const bool samp = (u.pm >= 16);
        if (u.pn >= 3) {
            const int cb = u.pn * 256 - 768 + wc * 64 + 8 * fq;
#pragma unroll
            for (int ai = 0; ai < 2; ++ai)
#pragma unroll
                for (int m = 0; m < 4; ++m) { bf16_t* rp = BCH + (size_t)(row0 + ai * HALF + m * 16) * 1536 + cb;
#pragma unroll
                    for (int bj = 0; bj < 2; ++bj) { const f32x4 v0 = acc[ai][bj][m][0], v1 = acc[ai][bj][m][1];
                        u32x4 w; w.x = pk2(v0[0], v0[1]); w.y = pk2(v0[2], v0[3]); w.z = pk2(v1[0], v1[1]); w.w = pk2(v1[2], v1[3]); *(u32x4*)(rp + 32 * bj) = w; } }
            return;
        }
        const bool isv = (u.pn == 2 && wc >= 2);
        if (!isv) {
            const bool isq = u.pn < 2;
            const float* gsrc = isq ? qg : kg;
            f32x4 gg[2][2];
#pragma unroll
            for (int bj = 0; bj < 2; ++bj)
#pragma unroll
                for (int n = 0; n < 2; ++n) gg[bj][n] = *(const f32x4*)(gsrc + 32 * bj + 16 * n + 4 * fq);
            const int head = isq ? u.pn * 4 + wc : wc;
#pragma unroll
            for (int ai = 0; ai < 2; ++ai)
#pragma unroll
                for (int m = 0; m < 4; ++m) {
                    const int row = row0 + ai * HALF + m * 16;
                    float ss = 0.f;
#pragma unroll
                    for (int bj = 0; bj < 2; ++bj)
#pragma unroll
                        for (int n = 0; n < 2; ++n) { const f32x4 v = acc[ai][bj][m][n]; ss += (v[0] * v[0] + v[1] * v[1]) + (v[2] * v[2] + v[3] * v[3]); }
                    ss = xsum32(xsum16(ss));
                    const float rstd = rsqrtf(ss * (1.0f / 64.0f) + 1e-6f);
                    f32x4 v[2][2];
#pragma unroll
                    for (int bj = 0; bj < 2; ++bj)
#pragma unroll
                        for (int n = 0; n < 2; ++n) v[bj][n] = acc[ai][bj][m][n] * rstd * gg[bj][n];
                    if (samp) {
                        const int t = (row - MP) & 2047; const int pr = t >> 6, pc = t & 63;
#pragma unroll
                        for (int bj = 0; bj < 2; ++bj) {
                            const int pos = bj ? pc : pr; const f32x4* rp = (const f32x4*)(rope + pos * 16 + 4 * fq);
                            const f32x4 c01 = rp[0], c23 = rp[1];
                            const float cs[4] = {c01[0], c01[2], c23[0], c23[2]}, sn[4] = {c01[1], c01[3], c23[1], c23[3]};
#pragma unroll
                            for (int e = 0; e < 4; ++e) { const float x1 = v[bj][0][e], x2 = v[bj][1][e]; v[bj][0][e] = x1 * cs[e] - x2 * sn[e]; v[bj][1][e] = x2 * cs[e] + x1 * sn[e]; }
                        }
                    }
                    if (isq) { bf16_t* dp = Q + (size_t)row * 512 + head * 64 + 4 * fq;
#pragma unroll
                        for (int bj = 0; bj < 2; ++bj)
#pragma unroll
                            for (int n = 0; n < 2; ++n) { u32x2 w; w.x = pk2(v[bj][n][0], v[bj][n][1]); w.y = pk2(v[bj][n][2], v[bj][n][3]); st8(dp + 32 * bj + 16 * n, w); } }
                    else {
                        size_t cb; int t;
                        if (!samp) { t = row & 255; cb = (size_t)(((row >> 8) * 2 + head) * 8 + (t >> 5)) * 2048; }
                        else { const int r2 = row - MP; t = r2 & 2047; cb = 524288 + (size_t)(((r2 >> 11) * 2 + head) * 64 + (t >> 5)) * 2048; }
                        bf16_t* dp = Kb + cb + ((fq >> 1) * 32 + (t & 31)) * 8 + 4 * (fq & 1);
#pragma unroll
                        for (int bj = 0; bj < 2; ++bj)
#pragma unroll
                            for (int n = 0; n < 2; ++n) { u32x2 w; w.x = pk2(v[bj][n][0], v[bj][n][1]); w.y = pk2(v[bj][n][2], v[bj][n][3]); *(u32x2*)(dp + (2 * bj + n) * 512) = w; } }
                    if (!isq && !samp) { float* op = outK + ((size_t)row * 2 + head) * 64 + 4 * fq;
#pragma unroll
                        for (int bj = 0; bj < 2; ++bj)
#pragma unroll
                            for (int n = 0; n < 2; ++n) *(f32x4*)(op + 32 * bj + 16 * n) = v[bj][n]; }
                }
        } else {
            const int hv = wc - 2;
#pragma unroll
            for (int ai = 0; ai < 2; ++ai)
#pragma unroll
                for (int m = 0; m < 4; ++m) {
                    const int row = row0 + ai * HALF + m * 16;
                    bf16_t* vb; size_t vs;
                    if (!samp) {
                        float* op = outV + ((size_t)row * 2 + hv) * 64 + 4 * fq;
#pragma unroll
                        for (int bj = 0; bj < 2; ++bj)
#pragma unroll
                            for (int n = 0; n < 2; ++n) *(f32x4*)(op + 32 * bj + 16 * n) = acc[ai][bj][m][n];
                        const int t = row & 255; vb = Vt + (size_t)(((row >> 8) * 2 + hv) * 8 + (t >> 5)) * 2048; vs = t & 31;
                    } else { const int r2 = row - MP; const int t = r2 & 2047; vb = Vt + 524288 + (size_t)(((r2 >> 11) * 2 + hv) * 64 + (t >> 5)) * 2048; vs = t & 31; }
                    { const int tk = (int)vs; const int ks = tk >> 4, kk = tk & 15; vb += (ks * 64 + ((kk >> 2) & 1) * 32) * 8 + 4 * (kk >> 3) + (kk & 3); }
#pragma unroll
                    for (int bj = 0; bj < 2; ++bj)
#pragma unroll
                        for (int n = 0; n < 2; ++n)
#pragma unroll
                            for (int e = 0; e < 4; ++e) vb[(bj * 128 + 16 * n + 4 * fq + e) * 8] = f2bf(acc[ai][bj][m][n][e]);
                }
        }
    }
};

struct EpiResid {
    static constexpr bool PERM = true;
    const float* xp; const float* xs; const bf16_t* xb;
    float* out; bf16_t* outb;
    const float* gate;
    bf16_t* Aout; const float* gs; float* rss;
    DI void operator()(f32x4 (&acc)[2][2][4][2], const Unit& u, int wr, int wc, int fr_, int fq_) const {
        int fr = fr_, fq = fq_; asm volatile("" : "+v"(fr), "+v"(fq));
        const int row0 = u.pm * BM + wr * 64 + fr, col0 = u.pn * BM + wc * 32 + 8 * fq;
        const int cond = u.pm < 16 ? 0 : 1 + ((u.pm - 16) >> 3);
        const float* gp = gate + cond * 6144 + col0;
        f32x4 gv[2][2], gsv[2][2];
#pragma unroll
        for (int bj = 0; bj < 2; ++bj)
#pragma unroll
            for (int n = 0; n < 2; ++n) { gv[bj][n] = *(const f32x4*)(gp + bj * HALF + 4 * n); gsv[bj][n] = Aout ? *(const f32x4*)(gs + cond * 1024 + col0 + bj * HALF + 4 * n) : (f32x4){0.f, 0.f, 0.f, 0.f}; }
#pragma unroll
        for (int ai = 0; ai < 2; ++ai)
#pragma unroll
            for (int m = 0; m < 4; ++m) {
                const int row = row0 + ai * HALF + m * 16;
                const size_t ro = (size_t)row * DM + col0;
                const float* xin = (row < MP ? xp + (size_t)row * DM : xs + (size_t)(row - MP) * DM) + col0;
                float ss = 0.f;
#pragma unroll
                for (int bj = 0; bj < 2; ++bj) { const int co = bj * HALF;
                    f32x4 x0, x1;
                    if (xb) { const u32x4 w = *(const u32x4*)(xb + ro + co); x0 = (f32x4){bflo(w.x), bfhi(w.x), bflo(w.y), bfhi(w.y)}; x1 = (f32x4){bflo(w.z), bfhi(w.z), bflo(w.w), bfhi(w.w)}; }
                    else { x0 = *(const f32x4*)(xin + co); x1 = *(const f32x4*)(xin + co + 4); }
                    const f32x4 n0 = x0 + gv[bj][0] * acc[ai][bj][m][0], n1 = x1 + gv[bj][1] * acc[ai][bj][m][1];
                    if (outb) { u32x4 w; w.x = pk2(n0[0], n0[1]); w.y = pk2(n0[2], n0[3]); w.z = pk2(n1[0], n1[1]); w.w = pk2(n1[2], n1[3]); *(u32x4*)(outb + ro + co) = w; }
                    else { *(f32x4*)(out + ro + co) = n0; *(f32x4*)(out + ro + co + 4) = n1; }
                    if (Aout) { ss += (n0[0] * n0[0] + n0[1] * n0[1]) + (n0[2] * n0[2] + n0[3] * n0[3]) + (n1[0] * n1[0] + n1[1] * n1[1]) + (n1[2] * n1[2] + n1[3] * n1[3]);
                        const f32x4 a0 = n0 * gsv[bj][0], a1 = n1 * gsv[bj][1];
                        u32x4 w; w.x = pk2(a0[0], a0[1]); w.y = pk2(a0[2], a0[3]); w.z = pk2(a1[0], a1[1]); w.w = pk2(a1[2], a1[3]); *(u32x4*)(Aout + ro + co) = w; } }
                if (Aout) { ss = xsum32(xsum16(ss)); if (fq == 0) atomicAdd(rss + row, ss); }
            }
    }
};

DI float silu_f(float x) { return x * __builtin_amdgcn_rcpf(1.0f + __builtin_amdgcn_exp2f(-1.4426950408889634f * x)); }
#define DPP_SHR1(x)  __int_as_float(__builtin_amdgcn_update_dpp(0, __float_as_int(x), 0x111, 0xf, 0xf, true))
#define DPP_SHL1(x)  __int_as_float(__builtin_amdgcn_update_dpp(0, __float_as_int(x), 0x101, 0xf, 0xf, true))
#define DPP_SHL15(x) __int_as_float(__builtin_amdgcn_update_dpp(0, __float_as_int(x), 0x10f, 0xf, 0xf, true))
#define DPP_SHR15(x) __int_as_float(__builtin_amdgcn_update_dpp(0, __float_as_int(x), 0x11f, 0xf, 0xf, true))
struct EpiUpConv {
    static constexpr bool PERM = true;
    bf16_t* ACT; bf16_t* EDGE; const float* cw;
    const float* rss; const float* sw;
    DI void operator()(f32x4 (&acc)[2][2][4][2], const Unit& u, int wr, int wc, int fr_, int fq_) const {
        int fr = fr_, fq = fq_; asm volatile("" : "+v"(fr), "+v"(fq));
        {
            const int cond = u.pm < 16 ? 0 : 1 + ((u.pm - 16) >> 3);
            const float* sp = sw + (size_t)cond * 5632 + u.pn * 256 + wc * 32 + 8 * fq;
            f32x4 swv[2][2];
#pragma unroll
            for (int bj = 0; bj < 2; ++bj)
#pragma unroll
                for (int n = 0; n < 2; ++n) swv[bj][n] = *(const f32x4*)(sp + bj * HALF + 4 * n);
#pragma unroll
            for (int ai = 0; ai < 2; ++ai)
#pragma unroll
                for (int m = 0; m < 4; ++m) { const float rstd = rsqrtf(rss[u.pm * BM + ai * HALF + wr * 64 + 16 * m + fr] * (1.0f / 1024.0f) + 1e-6f);
#pragma unroll
                    for (int bj = 0; bj < 2; ++bj)
#pragma unroll
                        for (int n = 0; n < 2; ++n) acc[ai][bj][m][n] = acc[ai][bj][m][n] * rstd + swv[bj][n]; }
        }
#pragma unroll
        for (int n = 0; n < 2; ++n) {
            const int ch0 = u.pn * 128 + wc * 32 + 8 * fq + 4 * n;
            f32x4 wg[3], wv[3];
#pragma unroll
            for (int tp = 0; tp < 3; ++tp) { wg[tp] = *(const f32x4*)(cw + tp * 5632 + ch0); wv[tp] = *(const f32x4*)(cw + tp * 5632 + 2816 + ch0); }
#pragma unroll
            for (int ai = 0; ai < 2; ++ai) {
                const int rbase = u.pm * BM + ai * HALF + wr * 64;
#pragma unroll
                for (int m = 0; m < 4; ++m) {
                    const int row = rbase + 16 * m + fr;
                    float o[4];
#pragma unroll
                    for (int e = 0; e < 4; ++e) {
                        float cv[2];
#pragma unroll
                        for (int bj = 0; bj < 2; ++bj) {
                            const float x = acc[ai][bj][m][n][e];
                            const float w0 = bj ? wv[0][e] : wg[0][e], w1 = bj ? wv[1][e] : wg[1][e], w2 = bj ? wv[2][e] : wg[2][e];
                            float c = w1 * x;
                            c = __builtin_fmaf(DPP_SHR1(x), w0, c);
                            c = __builtin_fmaf(DPP_SHL1(x), w2, c);
                            if (m > 0) c = __builtin_fmaf(DPP_SHL15(acc[ai][bj][m > 0 ? m - 1 : 0][n][e]), w0, c);
                            if (m < 3) c = __builtin_fmaf(DPP_SHR15(acc[ai][bj][m < 3 ? m + 1 : 3][n][e]), w2, c);
                            cv[bj] = c;
                        }
                        o[e] = cv[0] * cv[1] * __builtin_amdgcn_rcpf(1.0f + __builtin_amdgcn_exp2f(-1.4426950408889634f * cv[0]));
                    }
                    const bool edge = (m == 0 && fr == 0) || (m == 3 && fr == 15);
                    if (!edge) { u32x2 w; w.x = pk2(o[0], o[1]); w.y = pk2(o[2], o[3]); st8(ACT + (size_t)row * 2816 + ch0, w); }
                    if ((m == 0 && fr < 2) || (m == 3 && fr >= 14)) {
                        const int slot = (m == 0) ? fr : fr - 12;
                        bf16_t* ep = EDGE + (size_t)((row >> 6) * 4 + slot) * 5632 + ch0;
                        const f32x4 g0 = acc[ai][0][m][n], v0 = acc[ai][1][m][n];
                        u32x2 w; w.x = pk2(g0[0], g0[1]); w.y = pk2(g0[2], g0[3]); *(u32x2*)ep = w;
                        u32x2 w2; w2.x = pk2(v0[0], v0[1]); w2.y = pk2(v0[2], v0[3]); *(u32x2*)(ep + 2816) = w2;
                    }
                }
            }
        }
    }
};

DI float gelu_tanh(float x) {
    const float y = (1.5957691216057308f * 1.4426950408889634f) * (x + 0.044715f * x * x * x);
    return x * __builtin_amdgcn_rcpf(1.0f + __builtin_amdgcn_exp2f(-y));
}
struct EpiInOdd {
    static constexpr bool PERM = true;
    bf16_t *UG, *V1; float* rss; const float* rssx; const float* sw;
    DI void operator()(f32x4 (&acc)[2][2][4][2], const Unit& u, int wr, int wc, int fr_, int fq_) const {
        int fr = fr_, fq = fq_; asm volatile("" : "+v"(fr), "+v"(fq));
        const int row0 = u.pm * BM + wr * 64 + fr, col0 = (u.pn & 3) * BM + wc * 32 + 8 * fq;
        const bool isv = u.pn >= 4;
        bf16_t* dst = isv ? V1 : UG;
        const int cond = u.pm < 16 ? 0 : 1 + ((u.pm - 16) >> 3);
        const float* sp = sw + (size_t)cond * 2048 + u.pn * 256 + wc * 32 + 8 * fq;
        f32x4 swv[2][2];
#pragma unroll
        for (int bj = 0; bj < 2; ++bj)
#pragma unroll
            for (int n = 0; n < 2; ++n) swv[bj][n] = *(const f32x4*)(sp + bj * HALF + 4 * n);
#pragma unroll
        for (int ai = 0; ai < 2; ++ai)
#pragma unroll
            for (int m = 0; m < 4; ++m) { const int row = row0 + ai * HALF + m * 16; bf16_t* rp = dst + (size_t)row * 1024 + col0; float ss = 0.f;
                const float rstd = rsqrtf(rssx[row] * (1.0f / 1024.0f) + 1e-6f);
#pragma unroll
                for (int bj = 0; bj < 2; ++bj) { f32x4 v0 = acc[ai][bj][m][0] * rstd + swv[bj][0], v1 = acc[ai][bj][m][1] * rstd + swv[bj][1];
#pragma unroll
                    for (int e = 0; e < 4; ++e) { v0[e] = gelu_tanh(v0[e]); v1[e] = gelu_tanh(v1[e]); ss += v0[e] * v0[e] + v1[e] * v1[e]; }
                    u32x4 w; w.x = pk2(v0[0], v0[1]); w.y = pk2(v0[2], v0[3]); w.z = pk2(v1[0], v1[1]); w.w = pk2(v1[2], v1[3]); st16(rp + bj * HALF, w); }
                if (isv) { ss = xsum32(xsum16(ss)); if (fq == 0) atomicAdd(rss + row, ss); }
            }
    }
};


DI void adaln_prep(const Params& p, LAS unsigned char* lds, int tid) {
    LAS float* S = (LAS float*)(lds + 66048);
    for (int i = tid; i < 5 * 1024; i += NT) { const int cd = i >> 10, k = i & 1023; const float v = cd == 0 ? p.c_ctx[k] : p.c_lat[(cd - 1) * 1024 + k]; S[i] = silu_f(v); }
    __syncthreads();
}
DI void adaln_task(const Params& p, LAS unsigned char* lds, int tid, int task) {
    LAS float* S = (LAS float*)(lds + 66048);
    LAS float* P = (LAS float*)(lds + 66048 + 20480);
    float* mod = (float*)(p.wsp() + OFF_MOD);
    const int cgp = tid & 7, kg = tid >> 3;
    const int l = task / 192, cc = task % 192;
    const float* wp = p.ada_w + ((size_t)l * 1024 + kg * 16) * 6144 + cc * 32 + 4 * cgp;
    f32x4 a[5];
#pragma unroll
    for (int cd = 0; cd < 5; ++cd) a[cd] = (f32x4){0.f, 0.f, 0.f, 0.f};
#pragma unroll
    for (int kk = 0; kk < 16; ++kk) { const f32x4 w = __builtin_nontemporal_load((const f32x4*)(wp + (size_t)kk * 6144));
#pragma unroll
        for (int cd = 0; cd < 5; ++cd) a[cd] += w * S[cd * 1024 + kg * 16 + kk]; }
#pragma unroll
    for (int cd = 0; cd < 5; ++cd)
#pragma unroll
        for (int e = 0; e < 4; ++e) P[(kg * 8 + cgp) * 20 + cd * 4 + e] = a[cd][e];
    __syncthreads();
    if (tid < 160) { const int cd = tid >> 5, col = tid & 31, cg2 = col >> 2, e = col & 3; float sacc = 0.f;
        for (int k2 = 0; k2 < 64; ++k2) sacc += P[(k2 * 8 + cg2) * 20 + cd * 4 + e];
        mod[(size_t)(l * 5 + cd) * 6144 + cc * 32 + col] = sacc + p.ada_b[l * 6144 + cc * 32 + col]; }
    __syncthreads();
}
DI void transpose_tile(const Params& p, LAS unsigned char* lds, int tid, int tile) {
    unsigned char* ws = p.wsp();
    LAS float* T = (LAS float*)lds;
    int t = tile; const float* src; bf16_t* dst; int K, N, perm = 0;
    if (t < 144) { src = p.w_in_even; dst = (bf16_t*)(ws + OFF_WT_IN_EVEN); K = 1024; N = 2304; perm = 1; }
    else if ((t -= 144) < 64) { src = p.w_out_even; dst = (bf16_t*)(ws + OFF_WT_OUT_EVEN); K = 1024; N = 1024; }
    else if ((t -= 64) < 128) { src = p.w_in_odd; dst = (bf16_t*)(ws + OFF_WT_IN_ODD); K = 1024; N = 2048; }
    else if ((t -= 128) < 64) { src = p.w_out_odd; dst = (bf16_t*)(ws + OFF_WT_OUT_ODD); K = 1024; N = 1024; }
    else if ((t -= 64) < 352) { src = p.w_up; dst = (bf16_t*)(ws + OFF_WT_UP); K = 1024; N = 5632; perm = 2; }
    else if ((t -= 352) < 352) { src = p.w_up + (size_t)1024 * 5632; dst = (bf16_t*)(ws + OFF_WT_UP + SZ_WT_UP); K = 1024; N = 5632; perm = 2; }
    else if ((t -= 352) < 176) { src = p.w_down; dst = (bf16_t*)(ws + OFF_WT_DOWN); K = 2816; N = 1024; }
    else { t -= 176; src = p.w_down + (size_t)2816 * 1024; dst = (bf16_t*)(ws + OFF_WT_DOWN + SZ_WT_DOWN); K = 2816; N = 1024; }
    const int tn = N >> 8; const int tk = t / tn, tnn = t - tk * tn; const int k0 = tk * 64, n0 = tnn * 256;
    {
        const int c4 = tid & 63, r0 = tid >> 6;
        f32x4 v[8];
#pragma unroll
        for (int i = 0; i < 8; ++i) v[i] = __builtin_nontemporal_load((const f32x4*)(src + (size_t)(k0 + r0 + 8 * i) * N + n0 + 4 * c4));
#pragma unroll
        for (int i = 0; i < 8; ++i) { LAS float* tp = T + (r0 + 8 * i) * 257 + 4 * c4; tp[0] = v[i][0]; tp[1] = v[i][1]; tp[2] = v[i][2]; tp[3] = v[i][3]; }
    }
    __syncthreads();
    {
        const int n = tid & 255, kh = tid >> 8;
        const int oc = n0 + n;
        int gcol = oc;
        if (perm == 1) { const int w32 = oc & 31;
            const int in32 = oc >= 768 ? 16 * ((w32 >> 2) & 1) + 4 * (w32 >> 3) + (w32 & 3) : w32;
            gcol = (oc & ~255) + ((oc >> 5) & 1) * 128 + ((oc >> 6) & 3) * 32 + in32; }
        if (perm == 2) { const int isv = oc >= 2816, j = isv ? oc - 2816 : oc; gcol = (j >> 7) * 256 + isv * 128 + (j & 127); }
        bf16_t* dp = dst + (size_t)gcol * K + k0 + 32 * kh;
#pragma unroll
        for (int q = 0; q < 4; ++q) { float f[8];
#pragma unroll
            for (int j = 0; j < 8; ++j) f[j] = T[(32 * kh + 8 * q + j) * 257 + n];
            *(u32x4*)(dp + 8 * q) = pack8(f); }
    }
    __syncthreads();
}
DI void wspatial_job(const Params& p, int tid, int j) {
    bf16_t* wsp = (bf16_t*)(p.wsp() + OFF_WSP);
    for (int i = j * 2048 + tid; i < (j + 1) * 2048; i += NT) { const f32x4 a = *(const f32x4*)(p.w_spatial + (size_t)i * 8), b = *(const f32x4*)(p.w_spatial + (size_t)i * 8 + 4);
        u32x4 w; w.x = pk2(a[0], a[1]); w.y = pk2(a[2], a[3]); w.z = pk2(b[0], b[1]); w.w = pk2(b[2], b[3]); *(u32x4*)(wsp + (size_t)i * 8) = w; }
}
DI void sw_chunk(const Params& p, int chunk, int lane) {
    unsigned char* ws = p.wsp();
    const float* mod = (const float*)(ws + OFF_MOD); float* SW = (float*)(ws + OFF_SW);
    const int r0 = chunk * 8;
    const bf16_t* wt; const float* sh; int nloc; float* dst; int N;
    if (r0 < 5632) { wt = (const bf16_t*)(ws + OFF_WT_UP); sh = mod + 3 * 1024; nloc = r0; dst = SW; N = 5632; }
    else if (r0 < 7680) { wt = (const bf16_t*)(ws + OFF_WT_IN_ODD); sh = mod + 5 * 6144; nloc = r0 - 5632; dst = SW + 5 * 5632; N = 2048; }
    else { wt = (const bf16_t*)(ws + OFF_WT_UP + SZ_WT_UP); sh = mod + 5 * 6144 + 3 * 1024; nloc = r0 - 7680; dst = SW + 5 * 7680; N = 5632; }
    float shv[5][16];
#pragma unroll
    for (int cd = 0; cd < 5; ++cd)
#pragma unroll
        for (int q = 0; q < 4; ++q) { const f32x4 v = *(const f32x4*)(sh + (size_t)cd * 6144 + lane * 16 + 4 * q); shv[cd][4 * q] = v[0]; shv[cd][4 * q + 1] = v[1]; shv[cd][4 * q + 2] = v[2]; shv[cd][4 * q + 3] = v[3]; }
    for (int rr = 0; rr < 8; ++rr) {
        const bf16_t* rp = wt + (size_t)(nloc + rr) * 1024 + lane * 16;
        const u32x4 wa = *(const u32x4*)rp, wb = *(const u32x4*)(rp + 8);
        float wf[16]; { float t8[8]; unpack8(wa, t8);
#pragma unroll
            for (int j = 0; j < 8; ++j) wf[j] = t8[j];
            unpack8(wb, t8);
#pragma unroll
            for (int j = 0; j < 8; ++j) wf[8 + j] = t8[j]; }
        float acc5[5];
#pragma unroll
        for (int cd = 0; cd < 5; ++cd) { float a = 0.f;
#pragma unroll
            for (int j = 0; j < 16; ++j) a += shv[cd][j] * wf[j];
            acc5[cd] = wave_sum(a); }
        if (lane == 0) {
#pragma unroll
            for (int cd = 0; cd < 5; ++cd) dst[(size_t)cd * N + nloc + rr] = acc5[cd]; }
    }
}
DI void gs_tables(const Params& p, int t_lo, int t_hi, int gtid, int gsz) {
    unsigned char* ws = p.wsp();
    const float* mod = (const float*)(ws + OFF_MOD); float* GS = (float*)(ws + OFF_GS);
    for (int i = t_lo * 5120 + gtid; i < t_hi * 5120; i += gsz) { const int t = i / 5120, cd = (i / 1024) % 5, k = i & 1023;
        const float g = t == 0 ? p.norm_ffn_g[k] : (t == 1 ? p.norm_mix_g[1024 + k] : p.norm_ffn_g[1024 + k]);
        const float sc = mod[(size_t)((t == 0 ? 0 : 5) + cd) * 6144 + (t == 1 ? 1 : 4) * 1024 + k];
        GS[i] = g * (1.0f + sc); }
}

DI void bg_run(const Params& p, LAS unsigned char* lds, int q) {
    OPAQUE_IDS();
    (void)bid_o; (void)gdim_o;
    const int tid = tid_o;
    unsigned* ctr = (unsigned*)(p.wsp() + OFF_BAR) + 16 * q;
    volatile LAS int* slot = (volatile LAS int*)(lds + PTAB_OFF + 248);
    const int njobs = q == 0 ? 592 : (q == 1 ? 280 : (q == 2 ? 728 : 120));
    bool prepped = false;
    for (;;) {
        if (tid == 0) *slot = (int)__hip_atomic_fetch_add(ctr, 1u, __ATOMIC_RELAXED, __HIP_MEMORY_SCOPE_AGENT);
        __syncthreads();
        const int j = *slot;
        __syncthreads();
        if (j >= njobs) break;
        if (q == 0) { const int tile = j < 64 ? 144 + j : (j < 416 ? 400 + (j - 64) : 1104 + (j - 416)); transpose_tile(p, lds, tid, tile); }
        else if (q == 1) {
            if (j < 192) { if (!prepped) { adaln_prep(p, lds, tid); prepped = true; } adaln_task(p, lds, tid, 192 + j); }
            else sw_chunk(p, (j - 192) * 8 + (tid >> 6), tid & 63);
        } else if (q == 2) {
            if (j < 720) { const int tile = j < 192 ? 208 + j : (j < 544 ? 752 + (j - 192) : 1280 + (j - 544)); transpose_tile(p, lds, tid, tile); }
            else wspatial_job(p, tid, j - 720);
        } else sw_chunk(p, 704 + j * 8 + (tid >> 6), tid & 63);
    }
}

DI void gs_l1_phase(const Params& p) { OPAQUE_IDS(); gs_tables(p, 1, 3, bid_o * NT + tid_o, gdim_o * NT); }
DI bool has_unit_n1024() { OPAQUE_IDS(); (void)tid_o; StaticOrder S; S.init(MROWS, 1024, gdim_o, bid_o); Unit u0; return S.next(0, u0); }

DI void phase0(const Params& p, LAS unsigned char* lds) {
    OPAQUE_IDS();
    const int tid = tid_o;
    unsigned char* ws = p.wsp();
    { float* rss = (float*)(ws + OFF_RSS); for (int i = bid_o * NT + tid; i < 4 * MROWS; i += gdim_o * NT) rss[i] = 0.f; }
    adaln_prep(p, lds, tid);
    for (int task = bid_o; task < 192; task += gdim_o) adaln_task(p, lds, tid, task);
    for (int j = gdim_o - 1 - bid_o; j < 144; j += gdim_o) transpose_tile(p, lds, tid, j);
    const int gtid = bid_o * NT + tid, gsz = gdim_o * NT;
    { bf16_t* kc = (bf16_t*)(ws + OFF_KC);
      for (int i = gtid; i < 32768; i += gsz) { const int r = i & 31, h = (i >> 5) & 1, sst = (i >> 6) & 3, chunk = (i >> 8) & 15, hk = (i >> 12) & 1, b = i >> 13;
          const float* sp = p.cache_k + ((size_t)(b * 512 + chunk * 32 + r) * 2 + hk) * 64 + sst * 16 + h * 8;
          const f32x4 a = *(const f32x4*)sp, bb = *(const f32x4*)(sp + 4);
          u32x4 w; w.x = pk2(a[0], a[1]); w.y = pk2(a[2], a[3]); w.z = pk2(bb[0], bb[1]); w.w = pk2(bb[2], bb[3]); *(u32x4*)(kc + (size_t)i * 8) = w; } }
    { bf16_t* vct = (bf16_t*)(ws + OFF_VCT);
      for (int i = gtid; i < 32768; i += gsz) { const int lr = i & 31, hh = (i >> 5) & 1, ks = (i >> 6) & 1, db = (i >> 7) & 1, chunk = (i >> 8) & 15, hk = (i >> 12) & 1, b = i >> 13; float f[8];
#pragma unroll
          for (int j = 0; j < 8; ++j) { const int key = chunk * 32 + 16 * ks + 8 * (j >> 2) + 4 * hh + (j & 3); f[j] = p.cache_v[((size_t)(b * 512 + key) * 2 + hk) * 64 + 32 * db + lr]; }
          *(u32x4*)(vct + (size_t)i * 8) = pack8(f); } }
    { f32x2* rope = (f32x2*)(ws + OFF_ROPE);
      for (int i = gtid; i < 1024; i += gsz) { const int pos = i >> 4, f = i & 15; const float inv = powf(10000.0f, -(float)f / 16.0f); const float ang = (float)pos * inv;
          float sv, cv; sincosf(ang, &sv, &cv); rope[i] = (f32x2){cv, sv}; } }
}

DI void modulate_phase(const float* xp, const float* xs, const float* g, const float* mod_l  , int shift_i, bf16_t* H) {
    OPAQUE_IDS();
    const int tid = tid_o, wid = tid >> 6, lane = tid & 63;
    const int W = gdim_o * 8;
    for (int row = bid_o * 8 + wid; row < MROWS; row += W) {
        const float* xr = row < MP ? xp + (size_t)row * DM : xs + (size_t)(row - MP) * DM;
        const int cond = row < MP ? 0 : 1 + ((row - MP) >> 11);
        f32x4 v[4]; float ss = 0.f;
#pragma unroll
        for (int i = 0; i < 4; ++i) { v[i] = __builtin_nontemporal_load((const f32x4*)(xr + 512 * (i >> 1) + 8 * lane + 4 * (i & 1))); ss += (v[i][0] * v[i][0] + v[i][1] * v[i][1]) + (v[i][2] * v[i][2] + v[i][3] * v[i][3]); }
        ss = wave_sum(ss);
        const float rstd = rsqrtf(ss * (1.0f / 1024.0f) + 1e-6f);
        const float* sh = mod_l + (size_t)cond * 6144 + shift_i * 1024; const float* sc = sh + 1024;
#pragma unroll
        for (int i2 = 0; i2 < 2; ++i2) { const int col = 512 * i2 + 8 * lane; f32x4 h[2];
#pragma unroll
            for (int q = 0; q < 2; ++q) { const f32x4 gg = *(const f32x4*)(g + col + 4 * q), s1 = *(const f32x4*)(sc + col + 4 * q), s0 = *(const f32x4*)(sh + col + 4 * q);
                h[q] = v[2 * i2 + q] * rstd * gg * (s1 + 1.0f) + s0; }
            u32x4 w; w.x = pk2(h[0][0], h[0][1]); w.y = pk2(h[0][2], h[0][3]); w.z = pk2(h[1][0], h[1][1]); w.w = pk2(h[1][2], h[1][3]); *(u32x4*)(H + (size_t)row * DM + col) = w; }
    }
}

DI void tables_phase(const Params& p) {
    OPAQUE_IDS();
    gs_tables(p, 0, 1, bid_o * NT + tid_o, gdim_o * NT);
}

#define MFMA32(a, b, c) __builtin_amdgcn_mfma_f32_32x32x16_bf16((a), (b), (c), 0, 0, 0)
DI void attn_phase(const Params& p) {
    OPAQUE_IDS();
    unsigned char* ws = p.wsp();
    const bf16_t* Q = (const bf16_t*)(ws + OFF_Q); const bf16_t* Kb = (const bf16_t*)(ws + OFF_KB); const bf16_t* Vt = (const bf16_t*)(ws + OFF_VT);
    const bf16_t* BCH = (const bf16_t*)(ws + OFF_BCH); const bf16_t* Kc = (const bf16_t*)(ws + OFF_KC); const bf16_t* Vct = (const bf16_t*)(ws + OFF_VCT);
    bf16_t* MIX = (bf16_t*)(ws + OFF_MIX);
    const int tid = tid_o, wid = tid >> 6, lane = tid & 63;
    const int vbid = (gdim_o % 8 == 0) ? (bid_o % 8) * (gdim_o / 8) + bid_o / 8 : bid_o;
    const int cW = gdim_o * 8 > 1024 ? gdim_o * 8 - 1024 : gdim_o * 8, cw0 = gdim_o * 8 > 1024 ? vbid * 8 + wid - 1024 : vbid * 8 + wid;
    for (int idx = cw0 >= 0 ? cw0 * 64 + lane : 1536 * 64; idx < 1536 * 64; idx += cW * 64) {
        const int rg = idx >> 6, cg8 = idx & 63; const int row0 = rg * 8, j0 = cg8 * 8;
        const int smask = row0 < MP ? 255 : 2047;
        float w0[8], w1[8], w2[8];
        { const f32x4 a = *(const f32x4*)(p.short_conv_w + j0), b = *(const f32x4*)(p.short_conv_w + j0 + 4); w0[0] = a[0]; w0[1] = a[1]; w0[2] = a[2]; w0[3] = a[3]; w0[4] = b[0]; w0[5] = b[1]; w0[6] = b[2]; w0[7] = b[3]; }
        { const f32x4 a = *(const f32x4*)(p.short_conv_w + 512 + j0), b = *(const f32x4*)(p.short_conv_w + 512 + j0 + 4); w1[0] = a[0]; w1[1] = a[1]; w1[2] = a[2]; w1[3] = a[3]; w1[4] = b[0]; w1[5] = b[1]; w1[6] = b[2]; w1[7] = b[3]; }
        { const f32x4 a = *(const f32x4*)(p.short_conv_w + 1024 + j0), b = *(const f32x4*)(p.short_conv_w + 1024 + j0 + 4); w2[0] = a[0]; w2[1] = a[1]; w2[2] = a[2]; w2[3] = a[3]; w2[4] = b[0]; w2[5] = b[1]; w2[6] = b[2]; w2[7] = b[3]; }
        u32x4 cw[10], hw[10], bw[8];
        const u32x4 z4 = {0u, 0u, 0u, 0u};
#pragma unroll
        for (int i = 0; i < 10; ++i) { const int r = row0 - 1 + i;
            const bool ok = (i == 0) ? ((row0 & smask) != 0) : (i == 9 ? (((row0 + 8) & smask) != 0) : true);
            if (ok) { cw[i] = __builtin_nontemporal_load((const u32x4*)(BCH + (size_t)r * 1536 + 512 + j0)); hw[i] = __builtin_nontemporal_load((const u32x4*)(BCH + (size_t)r * 1536 + 1024 + j0)); } else { cw[i] = z4; hw[i] = z4; } }
#pragma unroll
        for (int i = 0; i < 8; ++i) bw[i] = __builtin_nontemporal_load((const u32x4*)(BCH + (size_t)(row0 + i) * 1536 + j0));
        float pv[8], cv[8], nv[8];
        { float a[8], b[8]; unpack8(cw[0], a); unpack8(hw[0], b);
#pragma unroll
          for (int j = 0; j < 8; ++j) pv[j] = a[j] * b[j];
          unpack8(cw[1], a); unpack8(hw[1], b);
#pragma unroll
          for (int j = 0; j < 8; ++j) cv[j] = a[j] * b[j]; }
#pragma unroll
        for (int i = 0; i < 8; ++i) {
            float a[8], b[8], o[8]; unpack8(cw[i + 2], a); unpack8(hw[i + 2], b);
#pragma unroll
            for (int j = 0; j < 8; ++j) nv[j] = a[j] * b[j];
            unpack8(bw[i], a);
#pragma unroll
            for (int j = 0; j < 8; ++j) { o[j] = a[j] * (w0[j] * pv[j] + w1[j] * cv[j] + w2[j] * nv[j]); pv[j] = cv[j]; cv[j] = nv[j]; }
            st16(MIX + (size_t)(row0 + i) * DM + 512 + j0, pack8(o));
        }
    }
    const int h = lane >> 5, r = lane & 31;
    const int W = gdim_o * 8, gw = vbid * 8 + wid;
    const float C1 = 0.125f * 1.4426950408889634f;
    for (int unit = gw; unit < 3072; unit += W) {
        const bool samp = unit < 2048;
        int b, head, q0, row0, nband, clo; const bf16_t* kbase; const bf16_t* vbase;
        if (samp) { b = unit >> 9; head = (unit >> 6) & 7; q0 = (unit & 63) * 32; row0 = MP + b * 2048 + q0; const int hk = head >> 2;
            kbase = Kb + 524288 + (size_t)((b * 2 + hk) * 64) * 2048; vbase = Vt + 524288 + (size_t)((b * 2 + hk) * 64) * 2048;
            clo = q0 >= 128 ? 0 : (128 - q0) >> 5; int chi = (2144 - q0) >> 5; if (chi > 8) chi = 8; nband = chi - clo + 1; }
        else { const int u2 = unit - 2048; b = u2 >> 6; head = (u2 >> 3) & 7; q0 = (u2 & 7) * 32; row0 = b * 256 + q0; const int hk = head >> 2;
            kbase = Kb + (size_t)((b * 2 + hk) * 8) * 2048; vbase = Vt + (size_t)((b * 2 + hk) * 8) * 2048; clo = 0; nband = 8; }
        const int hk = head >> 2;
        const bf16_t* kcb = Kc + (size_t)((b * 2 + hk) * 16) * 2048; const bf16_t* vcb = Vct + (size_t)((b * 2 + hk) * 16) * 2048;
        const int nch = samp ? nband + 16 : nband;
        bf16x8 qf[4];
#pragma unroll
        for (int s = 0; s < 4; ++s) qf[s] = *(const bf16x8*)(Q + (size_t)(row0 + r) * 512 + head * 64 + 16 * s + 8 * h);
        float mrun = p.sink_logit[head] * 1.4426950408889634f, lrun = 1.0f;
        f32x16 O0, O1;
#pragma unroll
        for (int i = 0; i < 16; ++i) { O0[i] = 0.f; O1[i] = 0.f; }
        const bf16_t* kp; const bf16_t* vp; int mk;
#define CHUNK_PTRS(it) do { if ((it) < nband) { const int cc_ = clo + (it); const int ci_ = samp ? ((q0 - 128) >> 5) + cc_ : cc_; kp = kbase + (size_t)ci_ * 2048; vp = vbase + (size_t)ci_ * 2048; \
            mk = samp ? (cc_ == 0 ? 1 : (cc_ == 8 ? 2 : 0)) : 0; } else { const int ci_ = (it) - nband; kp = kcb + (size_t)ci_ * 2048; vp = vcb + (size_t)ci_ * 2048; mk = 0; } } while (0)
        bf16x8 kn[4], vn[4];
        CHUNK_PTRS(0);
#pragma unroll
        for (int s = 0; s < 4; ++s) { kn[s] = *(const bf16x8*)(kp + (s * 64 + lane) * 8); vn[s] = *(const bf16x8*)(vp + (s * 64 + lane) * 8); }
        for (int it = 0; it < nch; ++it) {
            CHUNK_PTRS(it);
            const int mkc = mk;
            bf16x8 kf[4], vf[4];
#pragma unroll
            for (int s = 0; s < 4; ++s) { kf[s] = kn[s]; vf[s] = vn[s]; }
            if (it + 1 < nch) { CHUNK_PTRS(it + 1);
#pragma unroll
                for (int s = 0; s < 4; ++s) { kn[s] = *(const bf16x8*)(kp + (s * 64 + lane) * 8); vn[s] = *(const bf16x8*)(vp + (s * 64 + lane) * 8); } }
            f32x16 sa;
#pragma unroll
            for (int i = 0; i < 16; ++i) sa[i] = 0.f;
#pragma unroll
            for (int s = 0; s < 4; ++s) sa = MFMA32(kf[s], qf[s], sa);
            float tv[16]; float cm = -1e30f;
            if (mkc != 0) {
#pragma unroll
                for (int i = 0; i < 16; ++i) { const int koff = (i & 3) + 8 * (i >> 2) + 4 * h;
                    const bool ok = (mkc == 1) ? (koff >= r) : (koff <= r);
                    sa[i] = ok ? sa[i] : -1e30f; }
            }
#pragma unroll
            for (int i = 0; i < 16; ++i) cm = fmaxf(cm, sa[i]);
            cm = xmax32(cm) * C1;
            const float mnew = fmaxf(mrun, cm);
            const float alpha = __builtin_amdgcn_exp2f(mrun - mnew);
            float ps = 0.f;
#pragma unroll
            for (int i = 0; i < 16; ++i) { tv[i] = __builtin_amdgcn_exp2f(__builtin_fmaf(sa[i], C1, -mnew)); ps += tv[i]; }
            ps = xsum32(ps);
            lrun = lrun * alpha + ps; mrun = mnew;
            if (__builtin_amdgcn_ballot_w64(alpha != 1.0f) != 0ull) {
#pragma unroll
                for (int i = 0; i < 16; ++i) { O0[i] *= alpha; O1[i] *= alpha; } }
#pragma unroll
            for (int ks = 0; ks < 2; ++ks) { u32x4 w; w.x = pk2(tv[8 * ks + 0], tv[8 * ks + 1]); w.y = pk2(tv[8 * ks + 2], tv[8 * ks + 3]); w.z = pk2(tv[8 * ks + 4], tv[8 * ks + 5]); w.w = pk2(tv[8 * ks + 6], tv[8 * ks + 7]);
                const bf16x8 pb = __builtin_bit_cast(bf16x8, w);
                O0 = MFMA32(vf[ks], pb, O0); O1 = MFMA32(vf[2 + ks], pb, O1); }
        }
#undef CHUNK_PTRS
        const float inv = 1.0f / lrun;
        bf16_t* op = MIX + (size_t)(row0 + r) * DM + head * 64 + 4 * h;
#pragma unroll
        for (int j = 0; j < 4; ++j) { u32x2 w; w.x = pk2(O0[4 * j] * inv, O0[4 * j + 1] * inv); w.y = pk2(O0[4 * j + 2] * inv, O0[4 * j + 3] * inv); st8(op + 8 * j, w);
            u32x2 w2; w2.x = pk2(O1[4 * j] * inv, O1[4 * j + 1] * inv); w2.y = pk2(O1[4 * j + 2] * inv, O1[4 * j + 3] * inv); st8(op + 32 + 8 * j, w2); }
    }
}

DI void spatial_phase(const Params& p, LAS unsigned char* lds) {
    OPAQUE_IDS();
    unsigned char* ws = p.wsp();
    const bf16_t* UG = (const bf16_t*)(ws + OFF_UG); const bf16_t* V1 = (const bf16_t*)(ws + OFF_V1); const bf16_t* WS = (const bf16_t*)(ws + OFF_WSP);
    const float* rss = (const float*)(ws + OFF_RSS); bf16_t* MIX = (bf16_t*)(ws + OFF_MIX);
    LAS bf16_t* VT = (LAS bf16_t*)lds;
    LAS float* RS = (LAS float*)(lds + 128 * 136 * 2);
    const int tid = tid_o, wid = tid >> 6, lane = tid & 63, h = lane >> 5, r = lane & 31;
    const int tb = wid >> 1, chh = wid & 1;
    for (int task = bid_o; task < 768; task += gdim_o) {
        const int chunk = task >> 3, g = task & 7; const int rowb = chunk * 128;
#pragma unroll
        for (int i = 0; i < 4; ++i) { const int e = tid + NT * i; const int s = e >> 4, c8 = e & 15;
            const u32x4 w = __builtin_nontemporal_load((const u32x4*)(V1 + (size_t)(rowb + s) * 1024 + g * 128 + c8 * 8)); *(LAS u32x4*)(VT + s * 136 + c8 * 8) = w; }
        if (tid < 128) RS[tid] = rsqrtf(rss[rowb + tid] * (1.0f / 1024.0f) + 1e-6f);
        const int t0 = tb * 32, c0 = chh * 64;
        u32x4 wpre[8];
#pragma unroll
        for (int kk = 0; kk < 8; ++kk) wpre[kk] = *(const u32x4*)(WS + (size_t)(g * 128 + t0 + r) * 128 + 16 * kk + 8 * h);
        bf16_t upre[2][16];
#pragma unroll
        for (int i = 0; i < 16; ++i) { const int t = t0 + (i & 3) + 8 * (i >> 2) + 4 * h; const size_t o = (size_t)(rowb + t) * 1024 + g * 128 + c0 + r; upre[0][i] = UG[o]; upre[1][i] = UG[o + 32]; }
        __syncthreads();
        f32x16 a0, a1;
#pragma unroll
        for (int i = 0; i < 16; ++i) { a0[i] = 0.f; a1[i] = 0.f; }
#pragma unroll
        for (int kk = 0; kk < 8; ++kk) {
            const int s0 = 16 * kk + 8 * h;
            const u32x4 wa = wpre[kk];
            float fa[8]; unpack8(wa, fa);
            const f32x4 r0 = *(const LAS f32x4*)(RS + s0), r1 = *(const LAS f32x4*)(RS + s0 + 4);
            fa[0] *= r0[0]; fa[1] *= r0[1]; fa[2] *= r0[2]; fa[3] *= r0[3]; fa[4] *= r1[0]; fa[5] *= r1[1]; fa[6] *= r1[2]; fa[7] *= r1[3];
            const bf16x8 af = __builtin_bit_cast(bf16x8, pack8(fa));
            bf16x8 b0, b1;
#pragma unroll
            for (int j = 0; j < 8; ++j) { b0[j] = (short)VT[(s0 + j) * 136 + c0 + r]; b1[j] = (short)VT[(s0 + j) * 136 + c0 + 32 + r]; }
            a0 = MFMA32(af, b0, a0); a1 = MFMA32(af, b1, a1);
        }
        const float vg0 = p.gmlp_norm_g[g * 128 + c0 + r], vg1 = p.gmlp_norm_g[g * 128 + c0 + 32 + r];
#pragma unroll
        for (int i = 0; i < 16; ++i) { const int t = t0 + (i & 3) + 8 * (i >> 2) + 4 * h; const float bs = p.b_spatial[g * 128 + t];
            const size_t o = (size_t)(rowb + t) * 1024 + g * 128 + c0 + r;
            const float u0 = bflo((unsigned)upre[0][i]), u1 = bflo((unsigned)upre[1][i]);
            MIX[o] = f2bf(u0 * (a0[i] * vg0 + bs)); MIX[o + 32] = f2bf(u1 * (a1[i] * vg1 + bs)); }
        __syncthreads();
    }
}

DI void edge_fixup(const bf16_t* EDGE, bf16_t* ACT, const float* cw  , int pm) {
    OPAQUE_IDS();
    (void)bid_o; (void)gdim_o;
    for (int idx = tid_o; idx < 2 * 352; idx += NT) {
        const int half = idx / 352, cgp = idx - half * 352, j0 = cgp * 8;
        f32x4 a[3][2], b[3][2];
#pragma unroll
        for (int tp = 0; tp < 3; ++tp)
#pragma unroll
            for (int hh = 0; hh < 2; ++hh) { a[tp][hh] = *(const f32x4*)(cw + tp * 5632 + j0 + 4 * hh); b[tp][hh] = *(const f32x4*)(cw + tp * 5632 + 2816 + j0 + 4 * hh); }
        u32x4 gw[4][3], vw[4][3];
        const u32x4 z4 = {0u, 0u, 0u, 0u};
#pragma unroll
        for (int q = 0; q < 4; ++q) {
            const int er = half * 4 + q;
            const int band = pm * 4 + (er >> 1), last = er & 1, row = band * 64 + (last ? 63 : 0);
            const int smask = row < MP ? 255 : 2047;
            const bf16_t *pp, *pc, *pn; bool okp = true, okn = true;
            if (!last) { pc = EDGE + (size_t)(band * 4 + 0) * 5632; pn = EDGE + (size_t)(band * 4 + 1) * 5632; okp = (row & smask) != 0; pp = EDGE + (size_t)((okp ? band - 1 : band) * 4 + 3) * 5632; }
            else { pp = EDGE + (size_t)(band * 4 + 2) * 5632; pc = EDGE + (size_t)(band * 4 + 3) * 5632; okn = ((row + 1) & smask) != 0; pn = EDGE + (size_t)((okn ? band + 1 : band) * 4 + 0) * 5632; }
            gw[q][0] = okp ? *(const u32x4*)(pp + j0) : z4; vw[q][0] = okp ? *(const u32x4*)(pp + 2816 + j0) : z4;
            gw[q][1] = *(const u32x4*)(pc + j0); vw[q][1] = *(const u32x4*)(pc + 2816 + j0);
            gw[q][2] = okn ? *(const u32x4*)(pn + j0) : z4; vw[q][2] = okn ? *(const u32x4*)(pn + 2816 + j0) : z4;
        }
#pragma unroll
        for (int q = 0; q < 4; ++q) {
            const int er = half * 4 + q;
            const int row = (pm * 4 + (er >> 1)) * 64 + ((er & 1) ? 63 : 0);
            float gp[8], gc[8], gn[8], vp[8], vc[8], vn[8], o[8];
            unpack8(gw[q][0], gp); unpack8(gw[q][1], gc); unpack8(gw[q][2], gn); unpack8(vw[q][0], vp); unpack8(vw[q][1], vc); unpack8(vw[q][2], vn);
#pragma unroll
            for (int hh = 0; hh < 2; ++hh)
#pragma unroll
                for (int e = 0; e < 4; ++e) { const int j = 4 * hh + e;
                    const float g = a[0][hh][e] * gp[j] + a[1][hh][e] * gc[j] + a[2][hh][e] * gn[j]; const float v = b[0][hh][e] * vp[j] + b[1][hh][e] * vc[j] + b[2][hh][e] * vn[j];
                    o[j] = silu_f(g) * v; }
            *(u32x4*)(ACT + (size_t)row * 2816 + j0) = pack8(o);
        }
    }
    asm volatile("s_waitcnt vmcnt(0)" ::: "memory");
    __syncthreads();
}

#define XB_TMO      128
#define XB_XCNT(j)  (256  + 64 * (j))
#define XB_XSUB(j)  (1280 + 64 * (j))
#define XB_XGEN(j)  (2304 + 64 * (j))
#define XB_TOP      3328
#define XB_TOPGEN   3392
#define XCD_BAR_WORDS 3456
#define XB_SPIN_CAP (1u << 20)
DI unsigned xb_ld(unsigned* p)              { return __hip_atomic_load(p, __ATOMIC_RELAXED, __HIP_MEMORY_SCOPE_AGENT); }
DI unsigned xb_add(unsigned* p, unsigned v) { return __hip_atomic_fetch_add(p, v, __ATOMIC_RELAXED, __HIP_MEMORY_SCOPE_AGENT); }
DI unsigned xb_xcc_id() { return (unsigned)__builtin_amdgcn_s_getreg((3 << 11) | 20) & 0xFu; }
#define XB_SPIN(cond, bar) do { unsigned _sp = 0; while (cond) { __builtin_amdgcn_s_sleep(1); \
    if ((++_sp & 255u) == 0u) { if (xb_ld(&(bar)[XB_TMO])) break; if (_sp > XB_SPIN_CAP) { atomicAdd(&(bar)[XB_TMO], 1u); break; } } } } while (0)
DI void xcd_barrier_complete(unsigned* bar, unsigned x, unsigned G, unsigned& nloc, unsigned& nx) {
    unsigned sum, cnt, mine, sp = 0u;
    for (;;) {
        sum = 0u; cnt = 0u; mine = 0u;
#pragma unroll
        for (unsigned j = 0; j < 16; ++j) { const unsigned c = xb_ld(&bar[XB_XCNT(j)]); sum += c; cnt += (c > 0u) ? 1u : 0u; mine = (j == x) ? c : mine; }
        if (sum == G) break;
        __builtin_amdgcn_s_sleep(1);
        if ((++sp & 255u) == 0u) { if (xb_ld(&bar[XB_TMO])) break; if (sp > XB_SPIN_CAP) { atomicAdd(&bar[XB_TMO], 1u); break; } }
    }
    nloc = mine > 0u ? mine : 1u; nx = cnt > 0u ? cnt : 1u;
}
DI void xcd_barrier(unsigned* bar, volatile LAS unsigned* st) {
    asm volatile("s_waitcnt vmcnt(0)" ::: "memory");
    __syncthreads();
    if (threadIdx.x == 0) {
        const unsigned x = xb_xcc_id();
        __builtin_amdgcn_s_waitcnt(0);
        unsigned nloc = st[0], nx = st[1];
        if (nloc == 0u) { xcd_barrier_complete(bar, x, gridDim.x, nloc, nx); st[0] = nloc; st[1] = nx; }
        const unsigned old = xb_add(&bar[XB_XSUB(x)], 1u);
        const unsigned gen = old / nloc;
        if (old + 1u == (gen + 1u) * nloc) {
            __builtin_amdgcn_fence(__ATOMIC_RELEASE, "agent");
            asm volatile("s_waitcnt vmcnt(0)" ::: "memory");
            const unsigned og = xb_add(&bar[XB_TOP], 1u);
            const unsigned tg = og / nx;
            if (og + 1u == (tg + 1u) * nx) xb_add(&bar[XB_TOPGEN], 1u);
            else XB_SPIN(xb_ld(&bar[XB_TOPGEN]) == tg, bar);
            __builtin_amdgcn_fence(__ATOMIC_ACQUIRE, "agent");
            xb_add(&bar[XB_XGEN(x)], 1u);
            asm volatile("s_waitcnt vmcnt(0)" ::: "memory");
        } else {
            XB_SPIN(xb_ld(&bar[XB_XGEN(x)]) == gen, bar);
            __builtin_amdgcn_fence(__ATOMIC_ACQUIRE, "agent");
            asm volatile("s_waitcnt vmcnt(0)" ::: "memory");
        }
    }
    __syncthreads();
}

__global__ void __launch_bounds__(NT, 2) mega(KArgs ka) {
    extern __shared__ __attribute__((aligned(16))) unsigned char lds_raw[];
    LAS unsigned char* lds = (LAS unsigned char*)lds_raw;
    cg::grid_group grid = cg::this_grid();
    Params p; p.tab = (LAS unsigned long long*)(lds + PTAB_OFF);
    volatile LAS unsigned* bst = (volatile LAS unsigned*)(lds + PTAB_OFF + 240);
    if (threadIdx.x == 0) {
#pragma unroll
        for (int i = 0; i < 24; ++i) p.tab[i] = (unsigned long long)ka.in[i];
        p.tab[24] = (unsigned long long)ka.out; p.tab[25] = (unsigned long long)ka.ws;
        bst[0] = 0u; bst[1] = 0u;
        (void)xb_add(&((unsigned*)(ka.ws + OFF_BAR))[XB_XCNT(xb_xcc_id())], 1u);
    }
    __syncthreads();
    const int lo = ka.ph_lo, hi = ka.ph_hi;
#define IN(k) (lo <= (k) && (k) < hi)
    if (ka.ph_hi > 1000) grid.sync();
#define SEAM(k) do { if (IN(k) && IN((k) + 1)) xcd_barrier((unsigned*)(p.wsp() + OFF_BAR), bst); } while (0)

    if (IN(0)) for (int rep = 0; rep < REPS(0); ++rep) phase0(p, lds);
    SEAM(0);
    for (int layer = 0; layer < 2; ++layer) {
        if (layer == 0) {
            if (IN(1)) { unsigned char* ws = p.wsp();
                for (int rep = 0; rep < REPS(1); ++rep) modulate_phase(p.x_prompt, p.x_sample, p.norm_mix_g, (const float*)(ws + OFF_MOD), 0, (bf16_t*)(ws + OFF_H));
                tables_phase(p); }
            SEAM(1);
            if (IN(2)) { unsigned char* ws = p.wsp(); float* xo = p.outp();
                Gemm g{(const bf16_t*)(ws + OFF_H), (const bf16_t*)(ws + OFF_WT_IN_EVEN), MROWS, 2304, 1024};
                EpiInEven E{(bf16_t*)(ws + OFF_Q), (bf16_t*)(ws + OFF_KB), (bf16_t*)(ws + OFF_VT), (bf16_t*)(ws + OFF_BCH),
                            xo + (size_t)MROWS * DM, xo + (size_t)MROWS * DM + 524288, p.q_norm_g, p.k_norm_g, (const f32x2*)(ws + OFF_ROPE)};
                for (int rep = 0; rep < REPS(2); ++rep) gemm_phase(lds, g, E);
                bg_run(p, lds, 0);
            }
            SEAM(2);
            if (IN(3)) for (int rep = 0; rep < REPS(3); ++rep) attn_phase(p);
            SEAM(3);
        } else {
            if (IN(7)) { unsigned char* ws = p.wsp();
                Gemm g{(const bf16_t*)(ws + OFF_H), (const bf16_t*)(ws + OFF_WT_IN_ODD), MROWS, 2048, 1024};
                EpiInOdd E{(bf16_t*)(ws + OFF_UG), (bf16_t*)(ws + OFF_V1), (float*)(ws + OFF_RSS), (const float*)(ws + OFF_RSS) + 2 * MROWS, (const float*)(ws + OFF_SW) + 5 * 5632};
                gemm_phase(lds, g, E);
            }
            SEAM(7);
            if (IN(8)) for (int rep = 0; rep < REPS(11); ++rep) spatial_phase(p, lds);
            SEAM(8);
        }
        const int pb = layer == 0 ? 4 : 9;
        if (IN(pb)) { unsigned char* ws = p.wsp(); float* xo = p.outp();
            Gemm g{(const bf16_t*)(ws + OFF_MIX), (const bf16_t*)(ws + (layer == 0 ? OFF_WT_OUT_EVEN : OFF_WT_OUT_ODD)), MROWS, 1024, 1024};
            EpiResid E{p.x_prompt, p.x_sample, layer == 0 ? (const bf16_t*)nullptr : (const bf16_t*)(ws + OFF_XB), xo, (bf16_t*)(ws + OFF_XB),
                       (const float*)(ws + OFF_MOD) + (size_t)layer * 5 * 6144 + 2 * 1024,
                       (bf16_t*)(ws + OFF_H), (const float*)(ws + OFF_GS) + (layer == 0 ? 0 : 2) * 5120, (float*)(ws + OFF_RSS) + (layer == 0 ? 1 : 3) * MROWS};
            gemm_phase(lds, g, E);
            if (layer == 0) bg_run(p, lds, 1);
        }
        SEAM(pb);
        if (IN(pb + 1)) { unsigned char* ws = p.wsp();
            if (layer == 0) gs_l1_phase(p);
            Gemm g{(const bf16_t*)(ws + OFF_H), (const bf16_t*)(ws + OFF_WT_UP + (size_t)layer * SZ_WT_UP), MROWS, 5632, 1024};
            EpiUpConv E{(bf16_t*)(ws + OFF_ACT), (bf16_t*)(ws + OFF_EDGE), p.ffn_conv_w + (size_t)layer * 3 * 5632,
                        (const float*)(ws + OFF_RSS) + (layer == 0 ? 1 : 3) * MROWS, (const float*)(ws + OFF_SW) + (layer == 0 ? 0 : 5 * 7680)};
            gemm_phase(lds, g, E);
            if (layer == 0) bg_run(p, lds, 2);
        }
        SEAM(pb + 1);
        if (IN(pb + 2)) { unsigned char* ws = p.wsp(); float* xo = p.outp();
            { StaticOrder S; S.init(MROWS, 1024, (int)gridDim.x, (int)blockIdx.x); Unit u0;
              for (int i = 0; S.next(i, u0); ++i) edge_fixup((const bf16_t*)(ws + OFF_EDGE), (bf16_t*)(ws + OFF_ACT), p.ffn_conv_w + (size_t)layer * 3 * 5632, u0.pm); }
            Gemm g{(const bf16_t*)(ws + OFF_ACT), (const bf16_t*)(ws + OFF_WT_DOWN + (size_t)layer * SZ_WT_DOWN), MROWS, 1024, 2816};
            EpiResid E{xo, xo, (const bf16_t*)(ws + OFF_XB), xo, layer == 0 ? (bf16_t*)(ws + OFF_XB) : (bf16_t*)nullptr,
                       (const float*)(ws + OFF_MOD) + (size_t)layer * 5 * 6144 + 5 * 1024,
                       layer == 0 ? (bf16_t*)(ws + OFF_H) : (bf16_t*)nullptr, (const float*)(ws + OFF_GS) + 5120, (float*)(ws + OFF_RSS) + 2 * MROWS};
            gemm_phase(lds, g, E);
            if (layer == 0) bg_run(p, lds, 3);
        }
        SEAM(pb + 2);
    }
#undef IN
#undef SEAM
}

constexpr int LDS_TOTAL = LDS_BYTES + 256;
extern "C" void kernel_launch(void* const* d_in, const int* in_sizes, int n_in, void* d_out, int out_size, void* d_ws, size_t ws_size, hipStream_t stream) {
    static int grid = 0;
    if (grid == 0) {
        int dev = 0, cus = 0, per_cu = 0;
        (void)hipGetDevice(&dev);
        (void)hipDeviceGetAttribute(&cus, hipDeviceAttributeMultiprocessorCount, dev);
        if (hipFuncSetAttribute((const void*)mega, hipFuncAttributeMaxDynamicSharedMemorySize, LDS_TOTAL) != hipSuccess) { fprintf(stderr, "hipFuncSetAttribute failed\n"); grid = -1; return; }
        if (hipOccupancyMaxActiveBlocksPerMultiprocessor(&per_cu, (const void*)mega, NT, LDS_TOTAL) != hipSuccess || per_cu < 1) { fprintf(stderr, "occupancy query failed (%d)\n", per_cu); (void)hipGetLastError(); per_cu = 1; }
        if (per_cu > 1) per_cu = 1;
        grid = cus * per_cu;
    }
    if (grid < 0) return;
    KArgs ka{};
    for (int i = 0; i < 24; ++i) ka.in[i] = (const float*)d_in[i];
    ka.out = (float*)d_out; ka.ws = (unsigned char*)d_ws;
    if (hipMemsetAsync((unsigned char*)d_ws + OFF_BAR, 0, BAR_BYTES, stream) != hipSuccess) { fprintf(stderr, "memset failed\n"); return; }
#if COOP
    ka.ph_lo = 0; ka.ph_hi = 12;
    void* args[] = {&ka};
    hipError_t e = hipLaunchCooperativeKernel((const void*)mega, dim3(grid), dim3(NT), args, LDS_TOTAL, stream);
    if (e != hipSuccess) fprintf(stderr, "cooperative launch failed: %s (grid %d)\n", hipGetErrorString(e), grid);
#else
    for (int ph = 0; ph < 12; ++ph) { ka.ph_lo = ph; ka.ph_hi = ph + 1; hipLaunchKernelGGL(mega, dim3(grid), dim3(NT), LDS_TOTAL, stream, ka); }
#endif
}
```

```cpp
#include <hip/hip_runtime.h>
#include <hip/hip_cooperative_groups.h>
#include <cstdio>
namespace cg = cooperative_groups;

#ifndef COOP
#define COOP 1
#endif
#ifndef REPMASK
#define REPMASK 0
#endif
#define REPS(k) (1 + ((REPMASK >> (k)) & 1))

#define LAS __attribute__((address_space(3)))
#define DI __device__ __forceinline__
typedef unsigned short bf16_t;
typedef short bf16x8 __attribute__((ext_vector_type(8)));
typedef float f32x4 __attribute__((ext_vector_type(4)));
typedef float f32x2 __attribute__((ext_vector_type(2)));
typedef float f32x16 __attribute__((ext_vector_type(16)));
typedef unsigned u32x4 __attribute__((ext_vector_type(4)));
typedef unsigned u32x2 __attribute__((ext_vector_type(2)));
typedef __bf16 bf2_t __attribute__((ext_vector_type(2)));

DI unsigned pk2(float a, float b) { f32x2 v = {a, b}; bf2_t r = __builtin_convertvector(v, bf2_t); return __builtin_bit_cast(unsigned, r); }
DI float bflo(unsigned w) { return __uint_as_float(w << 16); }
DI float bfhi(unsigned w) { return __uint_as_float(w & 0xffff0000u); }
DI bf16_t f2bf(float a) { return (bf16_t)(pk2(a, 0.f) & 0xffffu); }
DI void unpack8(const u32x4 w, float (&f)[8]) {
    f[0] = bflo(w.x); f[1] = bfhi(w.x); f[2] = bflo(w.y); f[3] = bfhi(w.y); f[4] = bflo(w.z); f[5] = bfhi(w.z); f[6] = bflo(w.w); f[7] = bfhi(w.w);
}
DI u32x4 pack8(const float (&f)[8]) { u32x4 w; w.x = pk2(f[0], f[1]); w.y = pk2(f[2], f[3]); w.z = pk2(f[4], f[5]); w.w = pk2(f[6], f[7]); return w; }

DI float xsum32(float x) { auto r = __builtin_amdgcn_permlane32_swap(__float_as_uint(x), __float_as_uint(x), false, false); return __uint_as_float(r[0]) + __uint_as_float(r[1]); }
DI float xmax32(float x) { auto r = __builtin_amdgcn_permlane32_swap(__float_as_uint(x), __float_as_uint(x), false, false); return fmaxf(__uint_as_float(r[0]), __uint_as_float(r[1])); }
DI float xsum16(float x) { auto r = __builtin_amdgcn_permlane16_swap(__float_as_uint(x), __float_as_uint(x), false, false); return __uint_as_float(r[0]) + __uint_as_float(r[1]); }
DI float wave_sum(float x) {
    x += __int_as_float(__builtin_amdgcn_update_dpp(0, __float_as_int(x), 0x128, 0xf, 0xf, false));
    x += __int_as_float(__builtin_amdgcn_update_dpp(0, __float_as_int(x), 0x124, 0xf, 0xf, false));
    x += __int_as_float(__builtin_amdgcn_update_dpp(0, __float_as_int(x), 0x122, 0xf, 0xf, false));
    x += __int_as_float(__builtin_amdgcn_update_dpp(0, __float_as_int(x), 0x121, 0xf, 0xf, false));
    return xsum32(xsum16(x));
}
#ifndef WT_STORES
#define WT_STORES 0
#endif
DI void st8(void* p, u32x2 v) {
#if WT_STORES
    __hip_atomic_store((unsigned long long*)p, ((unsigned long long)v.y << 32) | v.x, __ATOMIC_RELAXED, __HIP_MEMORY_SCOPE_AGENT);
#else
    *(u32x2*)p = v;
#endif
}
DI void st16(void* p, u32x4 v) {
#if WT_STORES
    u32x2 a = {v.x, v.y}, b = {v.z, v.w}; st8(p, a); st8((char*)p + 8, b);
#else
    *(u32x4*)p = v;
#endif
}
DI void st16f(void* p, f32x4 v) { u32x4 w = {__float_as_uint(v[0]), __float_as_uint(v[1]), __float_as_uint(v[2]), __float_as_uint(v[3])}; st16(p, w); }
#define OPAQUE_IDS() int tid_o = threadIdx.x; asm volatile("" : "+v"(tid_o)); int bid_o = blockIdx.x; asm volatile("" : "+s"(bid_o)); int gdim_o = gridDim.x; asm volatile("" : "+s"(gdim_o))
constexpr int MROWS = 12288, DM = 1024, MP = 4096;
constexpr int NT = 512;
constexpr int LDS_BYTES = 131072;
constexpr size_t OFF_WT_IN_EVEN = 0;
constexpr size_t OFF_WT_OUT_EVEN = OFF_WT_IN_EVEN + 2304ull * 1024 * 2;
constexpr size_t OFF_WT_IN_ODD = OFF_WT_OUT_EVEN + 1024ull * 1024 * 2;
constexpr size_t OFF_WT_OUT_ODD = OFF_WT_IN_ODD + 2048ull * 1024 * 2;
constexpr size_t OFF_WT_UP = OFF_WT_OUT_ODD + 1024ull * 1024 * 2;
constexpr size_t SZ_WT_UP = 5632ull * 1024 * 2;
constexpr size_t OFF_WT_DOWN = OFF_WT_UP + 2 * SZ_WT_UP;
constexpr size_t SZ_WT_DOWN = 1024ull * 2816 * 2;
constexpr size_t OFF_WSP = OFF_WT_DOWN + 2 * SZ_WT_DOWN;
constexpr size_t OFF_KC = OFF_WSP + 8ull * 128 * 128 * 2;
constexpr size_t OFF_VCT = OFF_KC + 4ull * 512 * 128 * 2;
constexpr size_t OFF_ROPE = OFF_VCT + 4ull * 512 * 128 * 2;
constexpr size_t OFF_MOD = OFF_ROPE + 64ull * 16 * 8;
constexpr size_t OFF_RSS = OFF_MOD + 2ull * 5 * 6144 * 4;
constexpr size_t OFF_GS = OFF_RSS + 4ull * 12288 * 4;
constexpr size_t OFF_SW = OFF_GS + 3ull * 5 * 1024 * 4;
constexpr size_t OFF_BAR = ((OFF_SW + 5ull * 13312 * 4 + 4095) / 4096) * 4096;
constexpr size_t BAR_BYTES = 16384;
constexpr size_t OFF_ACT = OFF_BAR + BAR_BYTES;
constexpr size_t OFF_U = OFF_ACT + (size_t)MROWS * 2816 * 2;
constexpr size_t OFF_Q = OFF_U;
constexpr size_t OFF_KB = OFF_Q + (size_t)MROWS * 512 * 2;
constexpr size_t OFF_VT = OFF_KB + (size_t)MROWS * 128 * 2;
constexpr size_t OFF_BCH = OFF_VT + (size_t)MROWS * 128 * 2;
constexpr size_t OFF_MIX = OFF_BCH + (size_t)MROWS * 1536 * 2;
constexpr size_t OFF_UG = OFF_U;
constexpr size_t OFF_V1 = OFF_UG + (size_t)MROWS * 1024 * 2;
constexpr size_t OFF_EDGE = OFF_U;
constexpr size_t OFF_H = OFF_U + 84ull * 1024 * 1024;
constexpr size_t OFF_XB = OFF_U + 109ull * 1024 * 1024;
static_assert(OFF_MIX + (size_t)MROWS * 1024 * 2 <= OFF_H && OFF_H + (size_t)MROWS * 1024 * 2 <= OFF_XB && OFF_XB + (size_t)MROWS * 1024 * 2 <= 256ull * 1024 * 1024, "layout");
static_assert(OFF_V1 + (size_t)MROWS * 1024 * 2 <= OFF_MIX, "layout");


struct KArgs { const float* in[24]; float* out; unsigned char* ws; int ph_lo, ph_hi; };
constexpr int PTAB_OFF = LDS_BYTES;
struct Params {
    LAS unsigned long long* tab;
    DI unsigned long long raw(int i) const { const unsigned long long v = tab[i]; const unsigned lo = __builtin_amdgcn_readfirstlane((unsigned)v), hi = __builtin_amdgcn_readfirstlane((unsigned)(v >> 32)); return ((unsigned long long)hi << 32) | lo; }
    DI const float* in(int i) const { return (const float*)(const __attribute__((address_space(1))) float*)raw(i); }
    DI float* outp() const { return (float*)(__attribute__((address_space(1))) float*)raw(24); }
    DI unsigned char* wsp() const { return (unsigned char*)(__attribute__((address_space(1))) unsigned char*)raw(25); }
};
#define x_prompt in(0)
#define x_sample in(1)
#define cache_k in(2)
#define cache_v in(3)
#define c_lat in(4)
#define c_ctx in(5)
#define ada_w in(6)
#define ada_b in(7)
#define norm_mix_g in(8)
#define norm_ffn_g in(9)
#define w_in_even in(10)
#define q_norm_g in(11)
#define k_norm_g in(12)
#define sink_logit in(13)
#define short_conv_w in(14)
#define w_out_even in(15)
#define w_in_odd in(16)
#define gmlp_norm_g in(17)
#define w_spatial in(18)
#define b_spatial in(19)
#define w_out_odd in(20)
#define w_up in(21)
#define ffn_conv_w in(22)
#define w_down in(23)

constexpr int BM = 256, BK = 64, HALF = 128, HTB = HALF * BK * 2, NXCD = 8, WGM = 8;
DI int lds_byte(int r, int c) { const int st = (r >> 4) * 2 + (c >> 5), rr = r & 15, cc = c & 31, ob = rr * 64 + cc * 2; return st * 1024 + (ob ^ (((ob >> 9) & 1) << 5)); }
DI void stage_rc(int b, int& R, int& C) { const int st = b / 1024, sb = b % 1024, swz = sb ^ (((sb >> 9) & 1) << 5); R = (st >> 1) * 16 + swz / 64; C = (st & 1) * 32 + (swz % 64) / 2; }
DI int perm32(int rho) { const int n = rho >> 4, i = rho & 15; return 8 * (i >> 2) + 4 * n + (i & 3); }
struct Unit { int pm, pn; };
struct Gemm { const bf16_t* A; const bf16_t* Bt; int M, N, K; };
struct StaticOrder {
    int nM, nN, nwg, G, c;
    DI void init(int M, int N, int G_, int c_) { nM = M / BM; nN = N / BM; nwg = nM * nN; G = G_; c = c_; }
    DI bool next(int i, Unit& u) const {
        const long L = (long)i * G + c; if (L >= nwg) return false;
        int wgid = (int)L; { const int q = nwg / NXCD, r = nwg % NXCD, xcd = wgid % NXCD, off = wgid / NXCD; wgid = (xcd < r ? xcd * (q + 1) : r * (q + 1) + (xcd - r) * q) + off; }
        const int nig = WGM * nN, gid = wgid / nig, fm = gid * WGM, gsz = (nM - fm) < WGM ? (nM - fm) : WGM;
        u.pm = fm + ((wgid % nig) % gsz); u.pn = (wgid % nig) / gsz; return true;
    }
};

template <class Epi>
DI void gemm_phase(LAS unsigned char* lds, const Gemm g, const Epi& E) {
    OPAQUE_IDS();
    const int tid = tid_o, wid = __builtin_amdgcn_readfirstlane(tid >> 6), lane = tid & 63, wr = wid >> 2, wc = wid & 3, fr = lane & 15, fq = lane >> 4;
    const int K = g.K, nt = K / BK;
    StaticOrder S; S.init(g.M, g.N, gdim_o, bid_o);
    unsigned voffA[2], voffB[2];
#pragma unroll
    for (int i = 0; i < 2; ++i) { int R, C; stage_rc(tid * 16 + i * 8192, R, C); const int Rb = Epi::PERM ? ((R & ~31) + perm32(R & 31)) : R;
        voffA[i] = (unsigned)(R * K + C) * 2u; voffB[i] = (unsigned)(Rb * K + C) * 2u; }
    const size_t kstep = (size_t)(BK * 2);
    const size_t hstep = (size_t)HALF * K * 2;
    const size_t tstep = 2 * hstep;
    const unsigned ldsw = (unsigned)wid * 1024u;
    const int aoff = lds_byte(wr * 64 + fr, fq * 8), boff = lds_byte(wc * 32 + fr, fq * 8);
#define PG8_SA(b, h) (((b) * 2 + (h)) * HTB)
#define PG8_SB(b, h) ((4 + (b) * 2 + (h)) * HTB)
#define PG8_STAGE(bufoff, gbase, voff) do { _Pragma("unroll") for (int _i = 0; _i < 2; ++_i) \
        __builtin_amdgcn_global_load_lds((const unsigned*)((const char*)(gbase) + (voff)[_i]), (LAS unsigned*)(lds + (bufoff) + ldsw + _i * 8192), 16, 0, 0); } while (0)
#define PG8_LDA(dst, b, h) do { _Pragma("unroll") for (int m = 0; m < 4; ++m) _Pragma("unroll") for (int k = 0; k < 2; ++k) dst[m][k] = *(const LAS bf16x8*)(lds + PG8_SA(b, h) + aoff + m * 2048 + k * 1024); } while (0)
#define PG8_LDB(dst, b, h) do { _Pragma("unroll") for (int n = 0; n < 2; ++n) _Pragma("unroll") for (int k = 0; k < 2; ++k) dst[n][k] = *(const LAS bf16x8*)(lds + PG8_SB(b, h) + boff + n * 2048 + k * 1024); } while (0)
#define PG8_MMA(ai, bj, At, Bt) do { __builtin_amdgcn_s_setprio(1); _Pragma("unroll") for (int m = 0; m < 4; ++m) _Pragma("unroll") for (int n = 0; n < 2; ++n) _Pragma("unroll") for (int k = 0; k < 2; ++k) \
        acc[ai][bj][m][n] = __builtin_amdgcn_mfma_f32_16x16x32_bf16(Bt[n][k], At[m][k], acc[ai][bj][m][n], 0, 0, 0); __builtin_amdgcn_s_setprio(0); } while (0)
#define PG8_WAIT_V(n) asm volatile("s_waitcnt vmcnt(" #n ")" ::: "memory")
#define PG8_WAIT_L(n) asm volatile("s_waitcnt lgkmcnt(" #n ")" ::: "memory")
#define PG8_BAR __builtin_amdgcn_s_barrier()
#define PG8_SCHED __builtin_amdgcn_sched_barrier(0)
    Unit cur, nxt; int ui = 0;
    if (!S.next(0, cur)) return;
    f32x4 acc[2][2][4][2];
#pragma unroll
    for (int a = 0; a < 2; ++a)
#pragma unroll
        for (int b = 0; b < 2; ++b)
#pragma unroll
            for (int m = 0; m < 4; ++m)
#pragma unroll
                for (int n = 0; n < 2; ++n) acc[a][b][m][n] = (f32x4){0.f, 0.f, 0.f, 0.f};
    bf16x8 At[4][2], B0[2][2], B1[2][2];
    const char* cA = (const char*)g.A + (size_t)cur.pm * tstep; const char* cB = (const char*)g.Bt + (size_t)cur.pn * tstep;
    PG8_STAGE(PG8_SB(0, 0), cB, voffB); PG8_STAGE(PG8_SA(0, 0), cA, voffA); PG8_STAGE(PG8_SB(0, 1), cB + hstep, voffB); PG8_STAGE(PG8_SA(0, 1), cA + hstep, voffA);
    if (wr == 1) PG8_BAR;
    PG8_WAIT_V(4); PG8_BAR;
    PG8_STAGE(PG8_SB(1, 0), cB + kstep, voffB); PG8_STAGE(PG8_SA(1, 0), cA + kstep, voffA); PG8_STAGE(PG8_SB(1, 1), cB + hstep + kstep, voffB);
    PG8_WAIT_V(6); PG8_BAR;
    for (;;) {
        const bool has_next = S.next(ui + 1, nxt);
        const char* nA = has_next ? (const char*)g.A + (size_t)nxt.pm * tstep : cA; const char* nB = has_next ? (const char*)g.Bt + (size_t)nxt.pn * tstep : cB;
        for (int t = 0; t < nt; t += 2) {
            const bool last = (t == nt - 2);
            const char* a1 = cA + (size_t)(t + 1) * kstep;
            const char* a2 = last ? nA : cA + (size_t)(t + 2) * kstep; const char* b2 = last ? nB : cB + (size_t)(t + 2) * kstep;
            const char* a3 = a2 + kstep; const char* b3 = b2 + kstep;
            PG8_LDB(B0, 0, 0); PG8_SCHED; PG8_LDA(At, 0, 0); PG8_STAGE(PG8_SA(1, 1), a1 + hstep, voffA);
            PG8_WAIT_L(8); PG8_BAR; PG8_WAIT_L(0); PG8_MMA(0, 0, At, B0); PG8_BAR; PG8_SCHED;
            PG8_LDB(B1, 0, 1); PG8_STAGE(PG8_SB(0, 0), b2, voffB);
            PG8_BAR; PG8_WAIT_L(0); PG8_MMA(0, 1, At, B1); PG8_BAR;
            PG8_LDA(At, 0, 1); PG8_STAGE(PG8_SA(0, 0), a2, voffA);
            PG8_BAR; PG8_WAIT_L(0); PG8_MMA(1, 0, At, B0); PG8_BAR; PG8_SCHED;
            PG8_STAGE(PG8_SB(0, 1), b2 + hstep, voffB);
            PG8_WAIT_V(6); PG8_BAR; PG8_MMA(1, 1, At, B1); PG8_BAR;
            PG8_LDB(B0, 1, 0); PG8_SCHED; PG8_LDA(At, 1, 0); PG8_STAGE(PG8_SA(0, 1), a2 + hstep, voffA);
            PG8_WAIT_L(8); PG8_BAR; PG8_WAIT_L(0); PG8_MMA(0, 0, At, B0); PG8_BAR; PG8_SCHED;
            PG8_LDB(B1, 1, 1); PG8_STAGE(PG8_SB(1, 0), b3, voffB);
            PG8_BAR; PG8_WAIT_L(0); PG8_MMA(0, 1, At, B1); PG8_BAR;
            PG8_LDA(At, 1, 1); PG8_STAGE(PG8_SA(1, 0), a3, voffA);
            PG8_BAR; PG8_WAIT_L(0); PG8_MMA(1, 0, At, B0); PG8_BAR; PG8_SCHED;
            PG8_STAGE(PG8_SB(1, 1), b3 + hstep, voffB);
            PG8_WAIT_V(6); PG8_BAR; PG8_MMA(1, 1, At, B1); PG8_BAR;
        }
        E(acc, cur, wr, wc, fr, fq);
        if (!has_next) break;
#pragma unroll
        for (int a = 0; a < 2; ++a)
#pragma unroll
            for (int b = 0; b < 2; ++b)
#pragma unroll
                for (int m = 0; m < 4; ++m)
#pragma unroll
                    for (int n = 0; n < 2; ++n) acc[a][b][m][n] = (f32x4){0.f, 0.f, 0.f, 0.f};
        cur = nxt; cA = nA; cB = nB; ++ui;
    }
    PG8_WAIT_V(0);
    if (wr == 0) PG8_BAR;
    PG8_BAR;
#undef PG8_SA
#undef PG8_SB
#undef PG8_STAGE
#undef PG8_LDA
#undef PG8_LDB
#undef PG8_MMA
#undef PG8_WAIT_V
#undef PG8_WAIT_L
#undef PG8_BAR
#undef PG8_SCHED
}

struct EpiInEven {
    static constexpr bool PERM = false;
    bf16_t *Q, *Kb, *Vt, *BCH; float *outK, *outV; const float *qg, *kg; const f32x2* rope;
    DI void operator()(f32x4 (&acc)[2][2][4][2], const Unit& u, int wr, int wc, int fr_, int fq_) const {
        int fr = fr_, fq = fq_; asm volatile("" : "+v"(fr), "+v"(fq));
        const int row0 = u.pm * BM + wr * 64 + fr;
        const bool samp = (u.pm >= 16);
        if (u.pn >= 3) {
            const int cb = u.pn * 256 - 768 + wc * 64 + 8 * fq;
#pragma unroll
            for (int ai = 0; ai < 2; ++ai)
#pragma unroll
                for (int m = 0; m < 4; ++m) { bf16_t* rp = BCH + (size_t)(row0 + ai * HALF + m * 16) * 1536 + cb;
#pragma unroll
                    for (int bj = 0; bj < 2; ++bj) { const f32x4 v0 = acc[ai][bj][m][0], v1 = acc[ai][bj][m][1];
                        u32x4 w; w.x = pk2(v0[0], v0[1]); w.y = pk2(v0[2], v0[3]); w.z = pk2(v1[0], v1[1]); w.w = pk2(v1[2], v1[3]); *(u32x4*)(rp + 32 * bj) = w; } }
            return;
        }
        const bool isv = (u.pn == 2 && wc >= 2);
        if (!isv) {
            const bool isq = u.pn < 2;
            const float* gsrc = isq ? qg : kg;
            f32x4 gg[2][2];
#pragma unroll
            for (int bj = 0; bj < 2; ++bj)
#pragma unroll
                for (int n = 0; n < 2; ++n) gg[bj][n] = *(const f32x4*)(gsrc + 32 * bj + 16 * n + 4 * fq);
            const int head = isq ? u.pn * 4 + wc : wc;
#pragma unroll
            for (int ai = 0; ai < 2; ++ai)
#pragma unroll
                for (int m = 0; m < 4; ++m) {
                    const int row = row0 + ai * HALF + m * 16;
                    float ss = 0.f;
#pragma unroll
                    for (int bj = 0; bj < 2; ++bj)
#pragma unroll
                        for (int n = 0; n < 2; ++n) { const f32x4 v = acc[ai][bj][m][n]; ss += (v[0] * v[0] + v[1] * v[1]) + (v[2] * v[2] + v[3] * v[3]); }
                    ss = xsum32(xsum16(ss));
                    const float rstd = rsqrtf(ss * (1.0f / 64.0f) + 1e-6f);
                    f32x4 v[2][2];
#pragma unroll
                    for (int bj = 0; bj < 2; ++bj)
#pragma unroll
                        for (int n = 0; n < 2; ++n) v[bj][n] = acc[ai][bj][m][n] * rstd * gg[bj][n];
                    if (samp) {
                        const int t = (row - MP) & 2047; const int pr = t >> 6, pc = t & 63;
#pragma unroll
                        for (int bj = 0; bj < 2; ++bj) {
                            const int pos = bj ? pc : pr; const f32x4* rp = (const f32x4*)(rope + pos * 16 + 4 * fq);
                            const f32x4 c01 = rp[0], c23 = rp[1];
                            const float cs[4] = {c01[0], c01[2], c23[0], c23[2]}, sn[4] = {c01[1], c01[3], c23[1], c23[3]};
#pragma unroll
                            for (int e = 0; e < 4; ++e) { const float x1 = v[bj][0][e], x2 = v[bj][1][e]; v[bj][0][e] = x1 * cs[e] - x2 * sn[e]; v[bj][1][e] = x2 * cs[e] + x1 * sn[e]; }
                        }
                    }
                    if (isq) { bf16_t* dp = Q + (size_t)row * 512 + head * 64 + 4 * fq;
#pragma unroll
                        for (int bj = 0; bj < 2; ++bj)
#pragma unroll
                            for (int n = 0; n < 2; ++n) { u32x2 w; w.x = pk2(v[bj][n][0], v[bj][n][1]); w.y = pk2(v[bj][n][2], v[bj][n][3]); st8(dp + 32 * bj + 16 * n, w); } }
                    else {
                        size_t cb; int t;
                        if (!samp) { t = row & 255; cb = (size_t)(((row >> 8) * 2 + head) * 8 + (t >> 5)) * 2048; }
                        else { const int r2 = row - MP; t = r2 & 2047; cb = 524288 + (size_t)(((r2 >> 11) * 2 + head) * 64 + (t >> 5)) * 2048; }
                        bf16_t* dp = Kb + cb + ((fq >> 1) * 32 + (t & 31)) * 8 + 4 * (fq & 1);
#pragma unroll
                        for (int bj = 0; bj < 2; ++bj)
#pragma unroll
                            for (int n = 0; n < 2; ++n) { u32x2 w; w.x = pk2(v[bj][n][0], v[bj][n][1]); w.y = pk2(v[bj][n][2], v[bj][n][3]); *(u32x2*)(dp + (2 * bj + n) * 512) = w; } }
                    if (!isq && !samp) { float* op = outK + ((size_t)row * 2 + head) * 64 + 4 * fq;
#pragma unroll
                        for (int bj = 0; bj < 2; ++bj)
#pragma unroll
                            for (int n = 0; n < 2; ++n) *(f32x4*)(op + 32 * bj + 16 * n) = v[bj][n]; }
                }
        } else {
            const int hv = wc - 2;
#pragma unroll
            for (int ai = 0; ai < 2; ++ai)
#pragma unroll
                for (int m = 0; m < 4; ++m) {
                    const int row = row0 + ai * HALF + m * 16;
                    bf16_t* vb; size_t vs;
                    if (!samp) {
                        float* op = outV + ((size_t)row * 2 + hv) * 64 + 4 * fq;
#pragma unroll
                        for (int bj = 0; bj < 2; ++bj)
#pragma unroll
                            for (int n = 0; n < 2; ++n) *(f32x4*)(op + 32 * bj + 16 * n) = acc[ai][bj][m][n];
                        const int t = row & 255; vb = Vt + (size_t)(((row >> 8) * 2 + hv) * 8 + (t >> 5)) * 2048; vs = t & 31;
                    } else { const int r2 = row - MP; const int t = r2 & 2047; vb = Vt + 524288 + (size_t)(((r2 >> 11) * 2 + hv) * 64 + (t >> 5)) * 2048; vs = t & 31; }
                    { const int tk = (int)vs; const int ks = tk >> 4, kk = tk & 15; vb += (ks * 64 + ((kk >> 2) & 1) * 32) * 8 + 4 * (kk >> 3) + (kk & 3); }
#pragma unroll
                    for (int bj = 0; bj < 2; ++bj)
#pragma unroll
                        for (int n = 0; n < 2; ++n)
#pragma unroll
                            for (int e = 0; e < 4; ++e) vb[(bj * 128 + 16 * n + 4 * fq + e) * 8] = f2bf(acc[ai][bj][m][n][e]);
                }
        }
    }
};

struct EpiResid {
    static constexpr bool PERM = true;
    const float* xp; const float* xs; const bf16_t* xb;
    float* out; bf16_t* outb;
    const float* gate;
    bf16_t* Aout; const float* gs; float* rss;
    DI void operator()(f32x4 (&acc)[2][2][4][2], const Unit& u, int wr, int wc, int fr_, int fq_) const {
        int fr = fr_, fq = fq_; asm volatile("" : "+v"(fr), "+v"(fq));
        const int row0 = u.pm * BM + wr * 64 + fr, col0 = u.pn * BM + wc * 32 + 8 * fq;
        const int cond = u.pm < 16 ? 0 : 1 + ((u.pm - 16) >> 3);
        const float* gp = gate + cond * 6144 + col0;
        f32x4 gv[2][2], gsv[2][2];
#pragma unroll
        for (int bj = 0; bj < 2; ++bj)
#pragma unroll
            for (int n = 0; n < 2; ++n) { gv[bj][n] = *(const f32x4*)(gp + bj * HALF + 4 * n); gsv[bj][n] = Aout ? *(const f32x4*)(gs + cond * 1024 + col0 + bj * HALF + 4 * n) : (f32x4){0.f, 0.f, 0.f, 0.f}; }
#pragma unroll
        for (int ai = 0; ai < 2; ++ai)
#pragma unroll
            for (int m = 0; m < 4; ++m) {
                const int row = row0 + ai * HALF + m * 16;
                const size_t ro = (size_t)row * DM + col0;
                const float* xin = (row < MP ? xp + (size_t)row * DM : xs + (size_t)(row - MP) * DM) + col0;
                float ss = 0.f;
#pragma unroll
                for (int bj = 0; bj < 2; ++bj) { const int co = bj * HALF;
                    f32x4 x0, x1;
                    if (xb) { const u32x4 w = *(const u32x4*)(xb + ro + co); x0 = (f32x4){bflo(w.x), bfhi(w.x), bflo(w.y), bfhi(w.y)}; x1 = (f32x4){bflo(w.z), bfhi(w.z), bflo(w.w), bfhi(w.w)}; }
                    else { x0 = *(const f32x4*)(xin + co); x1 = *(const f32x4*)(xin + co + 4); }
                    const f32x4 n0 = x0 + gv[bj][0] * acc[ai][bj][m][0], n1 = x1 + gv[bj][1] * acc[ai][bj][m][1];
                    if (outb) { u32x4 w; w.x = pk2(n0[0], n0[1]); w.y = pk2(n0[2], n0[3]); w.z = pk2(n1[0], n1[1]); w.w = pk2(n1[2], n1[3]); *(u32x4*)(outb + ro + co) = w; }
                    else { *(f32x4*)(out + ro + co) = n0; *(f32x4*)(out + ro + co + 4) = n1; }
                    if (Aout) { ss += (n0[0] * n0[0] + n0[1] * n0[1]) + (n0[2] * n0[2] + n0[3] * n0[3]) + (n1[0] * n1[0] + n1[1] * n1[1]) + (n1[2] * n1[2] + n1[3] * n1[3]);
                        const f32x4 a0 = n0 * gsv[bj][0], a1 = n1 * gsv[bj][1];
                        u32x4 w; w.x = pk2(a0[0], a0[1]); w.y = pk2(a0[2], a0[3]); w.z = pk2(a1[0], a1[1]); w.w = pk2(a1[2], a1[3]); *(u32x4*)(Aout + ro + co) = w; } }
                if (Aout) { ss = xsum32(xsum16(ss)); if (fq == 0) atomicAdd(rss + row, ss); }
            }
    }
};

DI float silu_f(float x) { return x * __builtin_amdgcn_rcpf(1.0f + __builtin_amdgcn_exp2f(-1.4426950408889634f * x)); }
#define DPP_SHR1(x)  __int_as_float(__builtin_amdgcn_update_dpp(0, __float_as_int(x), 0x111, 0xf, 0xf, true))
#define DPP_SHL1(x)  __int_as_float(__builtin_amdgcn_update_dpp(0, __float_as_int(x), 0x101, 0xf, 0xf, true))
#define DPP_SHL15(x) __int_as_float(__builtin_amdgcn_update_dpp(0, __float_as_int(x), 0x10f, 0xf, 0xf, true))
#define DPP_SHR15(x) __int_as_float(__builtin_amdgcn_update_dpp(0, __float_as_int(x), 0x11f, 0xf, 0xf, true))
struct EpiUpConv {
    static constexpr bool PERM = true;
    bf16_t* ACT; bf16_t* EDGE; const float* cw;
    const float* rss; const float* sw;
    DI void operator()(f32x4 (&acc)[2][2][4][2], const Unit& u, int wr, int wc, int fr_, int fq_) const {
        int fr = fr_, fq = fq_; asm volatile("" : "+v"(fr), "+v"(fq));
        {
            const int cond = u.pm < 16 ? 0 : 1 + ((u.pm - 16) >> 3);
            const float* sp = sw + (size_t)cond * 5632 + u.pn * 256 + wc * 32 + 8 * fq;
            f32x4 swv[2][2];
#pragma unroll
            for (int bj = 0; bj < 2; ++bj)
#pragma unroll
                for (int n = 0; n < 2; ++n) swv[bj][n] = *(const f32x4*)(sp + bj * HALF + 4 * n);
#pragma unroll
            for (int ai = 0; ai < 2; ++ai)
#pragma unroll
                for (int m = 0; m < 4; ++m) { const float rstd = rsqrtf(rss[u.pm * BM + ai * HALF + wr * 64 + 16 * m + fr] * (1.0f / 1024.0f) + 1e-6f);
#pragma unroll
                    for (int bj = 0; bj < 2; ++bj)
#pragma unroll
                        for (int n = 0; n < 2; ++n) acc[ai][bj][m][n] = acc[ai][bj][m][n] * rstd + swv[bj][n]; }
        }
#pragma unroll
        for (int n = 0; n < 2; ++n) {
            const int ch0 = u.pn * 128 + wc * 32 + 8 * fq + 4 * n;
            f32x4 wg[3], wv[3];
#pragma unroll
            for (int tp = 0; tp < 3; ++tp) { wg[tp] = *(const f32x4*)(cw + tp * 5632 + ch0); wv[tp] = *(const f32x4*)(cw + tp * 5632 + 2816 + ch0); }
#pragma unroll
            for (int ai = 0; ai < 2; ++ai) {
                const int rbase = u.pm * BM + ai * HALF + wr * 64;
#pragma unroll
                for (int m = 0; m < 4; ++m) {
                    const int row = rbase + 16 * m + fr;
                    float o[4];
#pragma unroll
                    for (int e = 0; e < 4; ++e) {
                        float cv[2];
#pragma unroll
                        for (int bj = 0; bj < 2; ++bj) {
                            const float x = acc[ai][bj][m][n][e];
                            const float w0 = bj ? wv[0][e] : wg[0][e], w1 = bj ? wv[1][e] : wg[1][e], w2 = bj ? wv[2][e] : wg[2][e];
                            float c = w1 * x;
                            c = __builtin_fmaf(DPP_SHR1(x), w0, c);
                            c = __builtin_fmaf(DPP_SHL1(x), w2, c);
                            if (m > 0) c = __builtin_fmaf(DPP_SHL15(acc[ai][bj][m > 0 ? m - 1 : 0][n][e]), w0, c);
                            if (m < 3) c = __builtin_fmaf(DPP_SHR15(acc[ai][bj][m < 3 ? m + 1 : 3][n][e]), w2, c);
                            cv[bj] = c;
                        }
                        o[e] = cv[0] * cv[1] * __builtin_amdgcn_rcpf(1.0f + __builtin_amdgcn_exp2f(-1.4426950408889634f * cv[0]));
                    }
                    const bool edge = (m == 0 && fr == 0) || (m == 3 && fr == 15);
                    if (!edge) { u32x2 w; w.x = pk2(o[0], o[1]); w.y = pk2(o[2], o[3]); st8(ACT + (size_t)row * 2816 + ch0, w); }
                    if ((m == 0 && fr < 2) || (m == 3 && fr >= 14)) {
                        const int slot = (m == 0) ? fr : fr - 12;
                        bf16_t* ep = EDGE + (size_t)((row >> 6) * 4 + slot) * 5632 + ch0;
                        const f32x4 g0 = acc[ai][0][m][n], v0 = acc[ai][1][m][n];
                        u32x2 w; w.x = pk2(g0[0], g0[1]); w.y = pk2(g0[2], g0[3]); *(u32x2*)ep = w;
                        u32x2 w2; w2.x = pk2(v0[0], v0[1]); w2.y = pk2(v0[2], v0[3]); *(u32x2*)(ep + 2816) = w2;
                    }
                }
            }
        }
    }
};

DI float gelu_tanh(float x) {
    const float y = (1.5957691216057308f * 1.4426950408889634f) * (x + 0.044715f * x * x * x);
    return x * __builtin_amdgcn_rcpf(1.0f + __builtin_amdgcn_exp2f(-y));
}
struct EpiInOdd {
    static constexpr bool PERM = true;
    bf16_t *UG, *V1; float* rss; const float* rssx; const float* sw;
    DI void operator()(f32x4 (&acc)[2][2][4][2], const Unit& u, int wr, int wc, int fr_, int fq_) const {
        int fr = fr_, fq = fq_; asm volatile("" : "+v"(fr), "+v"(fq));
        const int row0 = u.pm * BM + wr * 64 + fr, col0 = (u.pn & 3) * BM + wc * 32 + 8 * fq;
        const bool isv = u.pn >= 4;
        bf16_t* dst = isv ? V1 : UG;
        const int cond = u.pm < 16 ? 0 : 1 + ((u.pm - 16) >> 3);
        const float* sp = sw + (size_t)cond * 2048 + u.pn * 256 + wc * 32 + 8 * fq;
        f32x4 swv[2][2];
#pragma unroll
        for (int bj = 0; bj < 2; ++bj)
#pragma unroll
            for (int n = 0; n < 2; ++n) swv[bj][n] = *(const f32x4*)(sp + bj * HALF + 4 * n);
#pragma unroll
        for (int ai = 0; ai < 2; ++ai)
#pragma unroll
            for (int m = 0; m < 4; ++m) { const int row = row0 + ai * HALF + m * 16; bf16_t* rp = dst + (size_t)row * 1024 + col0; float ss = 0.f;
                const float rstd = rsqrtf(rssx[row] * (1.0f / 1024.0f) + 1e-6f);
#pragma unroll
                for (int bj = 0; bj < 2; ++bj) { f32x4 v0 = acc[ai][bj][m][0] * rstd + swv[bj][0], v1 = acc[ai][bj][m][1] * rstd + swv[bj][1];
#pragma unroll
                    for (int e = 0; e < 4; ++e) { v0[e] = gelu_tanh(v0[e]); v1[e] = gelu_tanh(v1[e]); ss += v0[e] * v0[e] + v1[e] * v1[e]; }
                    u32x4 w; w.x = pk2(v0[0], v0[1]); w.y = pk2(v0[2], v0[3]); w.z = pk2(v1[0], v1[1]); w.w = pk2(v1[2], v1[3]); st16(rp + bj * HALF, w); }
                if (isv) { ss = xsum32(xsum16(ss)); if (fq == 0) atomicAdd(rss + row, ss); }
            }
    }
};


DI void adaln_prep(const Params& p, LAS unsigned char* lds, int tid) {
    LAS float* S = (LAS float*)(lds + 66048);
    for (int i = tid; i < 5 * 1024; i += NT) { const int cd = i >> 10, k = i & 1023; const float v = cd == 0 ? p.c_ctx[k] : p.c_lat[(cd - 1) * 1024 + k]; S[i] = silu_f(v); }
    __syncthreads();
}
DI void adaln_task(const Params& p, LAS unsigned char* lds, int tid, int task) {
    LAS float* S = (LAS float*)(lds + 66048);
    LAS float* P = (LAS float*)(lds + 66048 + 20480);
    float* mod = (float*)(p.wsp() + OFF_MOD);
    const int cgp = tid & 7, kg = tid >> 3;
    const int l = task / 192, cc = task % 192;
    const float* wp = p.ada_w + ((size_t)l * 1024 + kg * 16) * 6144 + cc * 32 + 4 * cgp;
    f32x4 a[5];
#pragma unroll
    for (int cd = 0; cd < 5; ++cd) a[cd] = (f32x4){0.f, 0.f, 0.f, 0.f};
#pragma unroll
    for (int kk = 0; kk < 16; ++kk) { const f32x4 w = __builtin_nontemporal_load((const f32x4*)(wp + (size_t)kk * 6144));
#pragma unroll
        for (int cd = 0; cd < 5; ++cd) a[cd] += w * S[cd * 1024 + kg * 16 + kk]; }
#pragma unroll
    for (int cd = 0; cd < 5; ++cd)
#pragma unroll
        for (int e = 0; e < 4; ++e) P[(kg * 8 + cgp) * 20 + cd * 4 + e] = a[cd][e];
    __syncthreads();
    if (tid < 160) { const int cd = tid >> 5, col = tid & 31, cg2 = col >> 2, e = col & 3; float sacc = 0.f;
        for (int k2 = 0; k2 < 64; ++k2) sacc += P[(k2 * 8 + cg2) * 20 + cd * 4 + e];
        mod[(size_t)(l * 5 + cd) * 6144 + cc * 32 + col] = sacc + p.ada_b[l * 6144 + cc * 32 + col]; }
    __syncthreads();
}
DI void transpose_tile(const Params& p, LAS unsigned char* lds, int tid, int tile) {
    unsigned char* ws = p.wsp();
    LAS float* T = (LAS float*)lds;
    int t = tile; const float* src; bf16_t* dst; int K, N, perm = 0;
    if (t < 144) { src = p.w_in_even; dst = (bf16_t*)(ws + OFF_WT_IN_EVEN); K = 1024; N = 2304; perm = 1; }
    else if ((t -= 144) < 64) { src = p.w_out_even; dst = (bf16_t*)(ws + OFF_WT_OUT_EVEN); K = 1024; N = 1024; }
    else if ((t -= 64) < 128) { src = p.w_in_odd; dst = (bf16_t*)(ws + OFF_WT_IN_ODD); K = 1024; N = 2048; }
    else if ((t -= 128) < 64) { src = p.w_out_odd; dst = (bf16_t*)(ws + OFF_WT_OUT_ODD); K = 1024; N = 1024; }
    else if ((t -= 64) < 352) { src = p.w_up; dst = (bf16_t*)(ws + OFF_WT_UP); K = 1024; N = 5632; perm = 2; }
    else if ((t -= 352) < 352) { src = p.w_up + (size_t)1024 * 5632; dst = (bf16_t*)(ws + OFF_WT_UP + SZ_WT_UP); K = 1024; N = 5632; perm = 2; }
    else if ((t -= 352) < 176) { src = p.w_down; dst = (bf16_t*)(ws + OFF_WT_DOWN); K = 2816; N = 1024; }
    else { t -= 176; src = p.w_down + (size_t)2816 * 1024; dst = (bf16_t*)(ws + OFF_WT_DOWN + SZ_WT_DOWN); K = 2816; N = 1024; }
    const int tn = N >> 8; const int tk = t / tn, tnn = t - tk * tn; const int k0 = tk * 64, n0 = tnn * 256;
    {
        const int c4 = tid & 63, r0 = tid >> 6;
        f32x4 v[8];
#pragma unroll
        for (int i = 0; i < 8; ++i) v[i] = __builtin_nontemporal_load((const f32x4*)(src + (size_t)(k0 + r0 + 8 * i) * N + n0 + 4 * c4));
#pragma unroll
        for (int i = 0; i < 8; ++i) { LAS float* tp = T + (r0 + 8 * i) * 257 + 4 * c4; tp[0] = v[i][0]; tp[1] = v[i][1]; tp[2] = v[i][2]; tp[3] = v[i][3]; }
    }
    __syncthreads();
    {
        const int n = tid & 255, kh = tid >> 8;
        const int oc = n0 + n;
        int gcol = oc;
        if (perm == 1) { const int w32 = oc & 31;
            const int in32 = oc >= 768 ? 16 * ((w32 >> 2) & 1) + 4 * (w32 >> 3) + (w32 & 3) : w32;
            gcol = (oc & ~255) + ((oc >> 5) & 1) * 128 + ((oc >> 6) & 3) * 32 + in32; }
        if (perm == 2) { const int isv = oc >= 2816, j = isv ? oc - 2816 : oc; gcol = (j >> 7) * 256 + isv * 128 + (j & 127); }
        bf16_t* dp = dst + (size_t)gcol * K + k0 + 32 * kh;
#pragma unroll
        for (int q = 0; q < 4; ++q) { float f[8];
#pragma unroll
            for (int j = 0; j < 8; ++j) f[j] = T[(32 * kh + 8 * q + j) * 257 + n];
            *(u32x4*)(dp + 8 * q) = pack8(f); }
    }
    __syncthreads();
}
DI void wspatial_job(const Params& p, int tid, int j) {
    bf16_t* wsp = (bf16_t*)(p.wsp() + OFF_WSP);
    for (int i = j * 2048 + tid; i < (j + 1) * 2048; i += NT) { const f32x4 a = *(const f32x4*)(p.w_spatial + (size_t)i * 8), b = *(const f32x4*)(p.w_spatial + (size_t)i * 8 + 4);
        u32x4 w; w.x = pk2(a[0], a[1]); w.y = pk2(a[2], a[3]); w.z = pk2(b[0], b[1]); w.w = pk2(b[2], b[3]); *(u32x4*)(wsp + (size_t)i * 8) = w; }
}
DI void sw_chunk(const Params& p, int chunk, int lane) {
    unsigned char* ws = p.wsp();
    const float* mod = (const float*)(ws + OFF_MOD); float* SW = (float*)(ws + OFF_SW);
    const int r0 = chunk * 8;
    const bf16_t* wt; const float* sh; int nloc; float* dst; int N;
    if (r0 < 5632) { wt = (const bf16_t*)(ws + OFF_WT_UP); sh = mod + 3 * 1024; nloc = r0; dst = SW; N = 5632; }
    else if (r0 < 7680) { wt = (const bf16_t*)(ws + OFF_WT_IN_ODD); sh = mod + 5 * 6144; nloc = r0 - 5632; dst = SW + 5 * 5632; N = 2048; }
    else { wt = (const bf16_t*)(ws + OFF_WT_UP + SZ_WT_UP); sh = mod + 5 * 6144 + 3 * 1024; nloc = r0 - 7680; dst = SW + 5 * 7680; N = 5632; }
    float shv[5][16];
#pragma unroll
    for (int cd = 0; cd < 5; ++cd)
#pragma unroll
        for (int q = 0; q < 4; ++q) { const f32x4 v = *(const f32x4*)(sh + (size_t)cd * 6144 + lane * 16 + 4 * q); shv[cd][4 * q] = v[0]; shv[cd][4 * q + 1] = v[1]; shv[cd][4 * q + 2] = v[2]; shv[cd][4 * q + 3] = v[3]; }
    for (int rr = 0; rr < 8; ++rr) {
        const bf16_t* rp = wt + (size_t)(nloc + rr) * 1024 + lane * 16;
        const u32x4 wa = *(const u32x4*)rp, wb = *(const u32x4*)(rp + 8);
        float wf[16]; { float t8[8]; unpack8(wa, t8);
#pragma unroll
            for (int j = 0; j < 8; ++j) wf[j] = t8[j];
            unpack8(wb, t8);
#pragma unroll
            for (int j = 0; j < 8; ++j) wf[8 + j] = t8[j]; }
        float acc5[5];
#pragma unroll
        for (int cd = 0; cd < 5; ++cd) { float a = 0.f;
#pragma unroll
            for (int j = 0; j < 16; ++j) a += shv[cd][j] * wf[j];
            acc5[cd] = wave_sum(a); }
        if (lane == 0) {
#pragma unroll
            for (int cd = 0; cd < 5; ++cd) dst[(size_t)cd * N + nloc + rr] = acc5[cd]; }
    }
}
DI void gs_tables(const Params& p, int t_lo, int t_hi, int gtid, int gsz) {
    unsigned char* ws = p.wsp();
    const float* mod = (const float*)(ws + OFF_MOD); float* GS = (float*)(ws + OFF_GS);
    for (int i = t_lo * 5120 + gtid; i < t_hi * 5120; i += gsz) { const int t = i / 5120, cd = (i / 1024) % 5, k = i & 1023;
        const float g = t == 0 ? p.norm_ffn_g[k] : (t == 1 ? p.norm_mix_g[1024 + k] : p.norm_ffn_g[1024 + k]);
        const float sc = mod[(size_t)((t == 0 ? 0 : 5) + cd) * 6144 + (t == 1 ? 1 : 4) * 1024 + k];
        GS[i] = g * (1.0f + sc); }
}

DI void bg_run(const Params& p, LAS unsigned char* lds, int q) {
    OPAQUE_IDS();
    (void)bid_o; (void)gdim_o;
    const int tid = tid_o;
    unsigned* ctr = (unsigned*)(p.wsp() + OFF_BAR) + 16 * q;
    volatile LAS int* slot = (volatile LAS int*)(lds + PTAB_OFF + 248);
    const int njobs = q == 0 ? 592 : (q == 1 ? 280 : (q == 2 ? 728 : 120));
    bool prepped = false;
    for (;;) {
        if (tid == 0) *slot = (int)__hip_atomic_fetch_add(ctr, 1u, __ATOMIC_RELAXED, __HIP_MEMORY_SCOPE_AGENT);
        __syncthreads();
        const int j = *slot;
        __syncthreads();
        if (j >= njobs) break;
        if (q == 0) { const int tile = j < 64 ? 144 + j : (j < 416 ? 400 + (j - 64) : 1104 + (j - 416)); transpose_tile(p, lds, tid, tile); }
        else if (q == 1) {
            if (j < 192) { if (!prepped) { adaln_prep(p, lds, tid); prepped = true; } adaln_task(p, lds, tid, 192 + j); }
            else sw_chunk(p, (j - 192) * 8 + (tid >> 6), tid & 63);
        } else if (q == 2) {
            if (j < 720) { const int tile = j < 192 ? 208 + j : (j < 544 ? 752 + (j - 192) : 1280 + (j - 544)); transpose_tile(p, lds, tid, tile); }
            else wspatial_job(p, tid, j - 720);
        } else sw_chunk(p, 704 + j * 8 + (tid >> 6), tid & 63);
    }
}

DI void gs_l1_phase(const Params& p) { OPAQUE_IDS(); gs_tables(p, 1, 3, bid_o * NT + tid_o, gdim_o * NT); }
DI bool has_unit_n1024() { OPAQUE_IDS(); (void)tid_o; StaticOrder S; S.init(MROWS, 1024, gdim_o, bid_o); Unit u0; return S.next(0, u0); }

DI void phase0(const Params& p, LAS unsigned char* lds) {
    OPAQUE_IDS();
    const int tid = tid_o;
    unsigned char* ws = p.wsp();
    { float* rss = (float*)(ws + OFF_RSS); for (int i = bid_o * NT + tid; i < 4 * MROWS; i += gdim_o * NT) rss[i] = 0.f; }
    adaln_prep(p, lds, tid);
    for (int task = bid_o; task < 192; task += gdim_o) adaln_task(p, lds, tid, task);
    for (int j = gdim_o - 1 - bid_o; j < 144; j += gdim_o) transpose_tile(p, lds, tid, j);
    const int gtid = bid_o * NT + tid, gsz = gdim_o * NT;
    { bf16_t* kc = (bf16_t*)(ws + OFF_KC);
      for (int i = gtid; i < 32768; i += gsz) { const int r = i & 31, h = (i >> 5) & 1, sst = (i >> 6) & 3, chunk = (i >> 8) & 15, hk = (i >> 12) & 1, b = i >> 13;
          const float* sp = p.cache_k + ((size_t)(b * 512 + chunk * 32 + r) * 2 + hk) * 64 + sst * 16 + h * 8;
          const f32x4 a = *(const f32x4*)sp, bb = *(const f32x4*)(sp + 4);
          u32x4 w; w.x = pk2(a[0], a[1]); w.y = pk2(a[2], a[3]); w.z = pk2(bb[0], bb[1]); w.w = pk2(bb[2], bb[3]); *(u32x4*)(kc + (size_t)i * 8) = w; } }
    { bf16_t* vct = (bf16_t*)(ws + OFF_VCT);
      for (int i = gtid; i < 32768; i += gsz) { const int lr = i & 31, hh = (i >> 5) & 1, ks = (i >> 6) & 1, db = (i >> 7) & 1, chunk = (i >> 8) & 15, hk = (i >> 12) & 1, b = i >> 13; float f[8];
#pragma unroll
          for (int j = 0; j < 8; ++j) { const int key = chunk * 32 + 16 * ks + 8 * (j >> 2) + 4 * hh + (j & 3); f[j] = p.cache_v[((size_t)(b * 512 + key) * 2 + hk) * 64 + 32 * db + lr]; }
          *(u32x4*)(vct + (size_t)i * 8) = pack8(f); } }
    { f32x2* rope = (f32x2*)(ws + OFF_ROPE);
      for (int i = gtid; i < 1024; i += gsz) { const int pos = i >> 4, f = i & 15; const float inv = powf(10000.0f, -(float)f / 16.0f); const float ang = (float)pos * inv;
          float sv, cv; sincosf(ang, &sv, &cv); rope[i] = (f32x2){cv, sv}; } }
}

DI void modulate_phase(const float* xp, const float* xs, const float* g, const float* mod_l  , int shift_i, bf16_t* H) {
    OPAQUE_IDS();
    const int tid = tid_o, wid = tid >> 6, lane = tid & 63;
    const int W = gdim_o * 8;
    for (int row = bid_o * 8 + wid; row < MROWS; row += W) {
        const float* xr = row < MP ? xp + (size_t)row * DM : xs + (size_t)(row - MP) * DM;
        const int cond = row < MP ? 0 : 1 + ((row - MP) >> 11);
        f32x4 v[4]; float ss = 0.f;
#pragma unroll
        for (int i = 0; i < 4; ++i) { v[i] = __builtin_nontemporal_load((const f32x4*)(xr + 512 * (i >> 1) + 8 * lane + 4 * (i & 1))); ss += (v[i][0] * v[i][0] + v[i][1] * v[i][1]) + (v[i][2] * v[i][2] + v[i][3] * v[i][3]); }
        ss = wave_sum(ss);
        const float rstd = rsqrtf(ss * (1.0f / 1024.0f) + 1e-6f);
        const float* sh = mod_l + (size_t)cond * 6144 + shift_i * 1024; const float* sc = sh + 1024;
#pragma unroll
        for (int i2 = 0; i2 < 2; ++i2) { const int col = 512 * i2 + 8 * lane; f32x4 h[2];
#pragma unroll
            for (int q = 0; q < 2; ++q) { const f32x4 gg = *(const f32x4*)(g + col + 4 * q), s1 = *(const f32x4*)(sc + col + 4 * q), s0 = *(const f32x4*)(sh + col + 4 * q);
                h[q] = v[2 * i2 + q] * rstd * gg * (s1 + 1.0f) + s0; }
            u32x4 w; w.x = pk2(h[0][0], h[0][1]); w.y = pk2(h[0][2], h[0][3]); w.z = pk2(h[1][0], h[1][1]); w.w = pk2(h[1][2], h[1][3]); *(u32x4*)(H + (size_t)row * DM + col) = w; }
    }
}

DI void tables_phase(const Params& p) {
    OPAQUE_IDS();
    gs_tables(p, 0, 1, bid_o * NT + tid_o, gdim_o * NT);
}

#define MFMA32(a, b, c) __builtin_amdgcn_mfma_f32_32x32x16_bf16((a), (b), (c), 0, 0, 0)
DI void attn_phase(const Params& p) {
    OPAQUE_IDS();
    unsigned char* ws = p.wsp();
    const bf16_t* Q = (const bf16_t*)(ws + OFF_Q); const bf16_t* Kb = (const bf16_t*)(ws + OFF_KB); const bf16_t* Vt = (const bf16_t*)(ws + OFF_VT);
    const bf16_t* BCH = (const bf16_t*)(ws + OFF_BCH); const bf16_t* Kc = (const bf16_t*)(ws + OFF_KC); const bf16_t* Vct = (const bf16_t*)(ws + OFF_VCT);
    bf16_t* MIX = (bf16_t*)(ws + OFF_MIX);
    const int tid = tid_o, wid = tid >> 6, lane = tid & 63;
    const int cW = gdim_o * 8 > 1024 ? gdim_o * 8 - 1024 : gdim_o * 8, cw0 = gdim_o * 8 > 1024 ? bid_o * 8 + wid - 1024 : bid_o * 8 + wid;
    for (int idx = cw0 >= 0 ? cw0 * 64 + lane : 1536 * 64; idx < 1536 * 64; idx += cW * 64) {
        const int rg = idx >> 6, cg8 = idx & 63; const int row0 = rg * 8, j0 = cg8 * 8;
        const int smask = row0 < MP ? 255 : 2047;
        float w0[8], w1[8], w2[8];
        { const f32x4 a = *(const f32x4*)(p.short_conv_w + j0), b = *(const f32x4*)(p.short_conv_w + j0 + 4); w0[0] = a[0]; w0[1] = a[1]; w0[2] = a[2]; w0[3] = a[3]; w0[4] = b[0]; w0[5] = b[1]; w0[6] = b[2]; w0[7] = b[3]; }
        { const f32x4 a = *(const f32x4*)(p.short_conv_w + 512 + j0), b = *(const f32x4*)(p.short_conv_w + 512 + j0 + 4); w1[0] = a[0]; w1[1] = a[1]; w1[2] = a[2]; w1[3] = a[3]; w1[4] = b[0]; w1[5] = b[1]; w1[6] = b[2]; w1[7] = b[3]; }
        { const f32x4 a = *(const f32x4*)(p.short_conv_w + 1024 + j0), b = *(const f32x4*)(p.short_conv_w + 1024 + j0 + 4); w2[0] = a[0]; w2[1] = a[1]; w2[2] = a[2]; w2[3] = a[3]; w2[4] = b[0]; w2[5] = b[1]; w2[6] = b[2]; w2[7] = b[3]; }
        u32x4 cw[10], hw[10], bw[8];
        const u32x4 z4 = {0u, 0u, 0u, 0u};
#pragma unroll
        for (int i = 0; i < 10; ++i) { const int r = row0 - 1 + i;
            const bool ok = (i == 0) ? ((row0 & smask) != 0) : (i == 9 ? (((row0 + 8) & smask) != 0) : true);
            if (ok) { cw[i] = __builtin_nontemporal_load((const u32x4*)(BCH + (size_t)r * 1536 + 512 + j0)); hw[i] = __builtin_nontemporal_load((const u32x4*)(BCH + (size_t)r * 1536 + 1024 + j0)); } else { cw[i] = z4; hw[i] = z4; } }
#pragma unroll
        for (int i = 0; i < 8; ++i) bw[i] = __builtin_nontemporal_load((const u32x4*)(BCH + (size_t)(row0 + i) * 1536 + j0));
        float pv[8], cv[8], nv[8];
        { float a[8], b[8]; unpack8(cw[0], a); unpack8(hw[0], b);
#pragma unroll
          for (int j = 0; j < 8; ++j) pv[j] = a[j] * b[j];
          unpack8(cw[1], a); unpack8(hw[1], b);
#pragma unroll
          for (int j = 0; j < 8; ++j) cv[j] = a[j] * b[j]; }
#pragma unroll
        for (int i = 0; i < 8; ++i) {
            float a[8], b[8], o[8]; unpack8(cw[i + 2], a); unpack8(hw[i + 2], b);
#pragma unroll
            for (int j = 0; j < 8; ++j) nv[j] = a[j] * b[j];
            unpack8(bw[i], a);
#pragma unroll
            for (int j = 0; j < 8; ++j) { o[j] = a[j] * (w0[j] * pv[j] + w1[j] * cv[j] + w2[j] * nv[j]); pv[j] = cv[j]; cv[j] = nv[j]; }
            st16(MIX + (size_t)(row0 + i) * DM + 512 + j0, pack8(o));
        }
    }
    const int h = lane >> 5, r = lane & 31;
    const int W = gdim_o * 8, gw = bid_o * 8 + wid;
    const float C1 = 0.125f * 1.4426950408889634f;
    for (int unit = gw; unit < 3072; unit += W) {
        const bool samp = unit < 2048;
        int b, head, q0, row0, nband, clo; const bf16_t* kbase; const bf16_t* vbase;
        if (samp) { b = unit >> 9; head = (unit >> 6) & 7; q0 = (unit & 63) * 32; row0 = MP + b * 2048 + q0; const int hk = head >> 2;
            kbase = Kb + 524288 + (size_t)((b * 2 + hk) * 64) * 2048; vbase = Vt + 524288 + (size_t)((b * 2 + hk) * 64) * 2048;
            clo = q0 >= 128 ? 0 : (128 - q0) >> 5; int chi = (2144 - q0) >> 5; if (chi > 8) chi = 8; nband = chi - clo + 1; }
        else { const int u2 = unit - 2048; b = u2 >> 6; head = (u2 >> 3) & 7; q0 = (u2 & 7) * 32; row0 = b * 256 + q0; const int hk = head >> 2;
            kbase = Kb + (size_t)((b * 2 + hk) * 8) * 2048; vbase = Vt + (size_t)((b * 2 + hk) * 8) * 2048; clo = 0; nband = 8; }
        const int hk = head >> 2;
        const bf16_t* kcb = Kc + (size_t)((b * 2 + hk) * 16) * 2048; const bf16_t* vcb = Vct + (size_t)((b * 2 + hk) * 16) * 2048;
        const int nch = samp ? nband + 16 : nband;
        bf16x8 qf[4];
#pragma unroll
        for (int s = 0; s < 4; ++s) qf[s] = *(const bf16x8*)(Q + (size_t)(row0 + r) * 512 + head * 64 + 16 * s + 8 * h);
        float mrun = p.sink_logit[head] * 1.4426950408889634f, lrun = 1.0f;
        f32x16 O0, O1;
#pragma unroll
        for (int i = 0; i < 16; ++i) { O0[i] = 0.f; O1[i] = 0.f; }
        const bf16_t* kp; const bf16_t* vp; int mk;
#define CHUNK_PTRS(it) do { if ((it) < nband) { const int cc_ = clo + (it); const int ci_ = samp ? ((q0 - 128) >> 5) + cc_ : cc_; kp = kbase + (size_t)ci_ * 2048; vp = vbase + (size_t)ci_ * 2048; \
            mk = samp ? (cc_ == 0 ? 1 : (cc_ == 8 ? 2 : 0)) : 0; } else { const int ci_ = (it) - nband; kp = kcb + (size_t)ci_ * 2048; vp = vcb + (size_t)ci_ * 2048; mk = 0; } } while (0)
        bf16x8 kn[4], vn[4];
        CHUNK_PTRS(0);
#pragma unroll
        for (int s = 0; s < 4; ++s) { kn[s] = *(const bf16x8*)(kp + (s * 64 + lane) * 8); vn[s] = *(const bf16x8*)(vp + (s * 64 + lane) * 8); }
        for (int it = 0; it < nch; ++it) {
            CHUNK_PTRS(it);
            const int mkc = mk;
            bf16x8 kf[4], vf[4];
#pragma unroll
            for (int s = 0; s < 4; ++s) { kf[s] = kn[s]; vf[s] = vn[s]; }
            if (it + 1 < nch) { CHUNK_PTRS(it + 1);
#pragma unroll
                for (int s = 0; s < 4; ++s) { kn[s] = *(const bf16x8*)(kp + (s * 64 + lane) * 8); vn[s] = *(const bf16x8*)(vp + (s * 64 + lane) * 8); } }
            f32x16 sa;
#pragma unroll
            for (int i = 0; i < 16; ++i) sa[i] = 0.f;
#pragma unroll
            for (int s = 0; s < 4; ++s) sa = MFMA32(kf[s], qf[s], sa);
            float tv[16]; float cm = -1e30f;
            if (mkc != 0) {
#pragma unroll
                for (int i = 0; i < 16; ++i) { const int koff = (i & 3) + 8 * (i >> 2) + 4 * h;
                    const bool ok = (mkc == 1) ? (koff >= r) : (koff <= r);
                    sa[i] = ok ? sa[i] : -1e30f; }
            }
#pragma unroll
            for (int i = 0; i < 16; ++i) cm = fmaxf(cm, sa[i]);
            cm = xmax32(cm) * C1;
            if (__builtin_amdgcn_ballot_w64(cm > mrun + 6.0f) != 0ull) {
                const float mnew = fmaxf(mrun, cm);
                const float alpha = __builtin_amdgcn_exp2f(mrun - mnew);
                lrun *= alpha; mrun = mnew;
#pragma unroll
                for (int i = 0; i < 16; ++i) { O0[i] *= alpha; O1[i] *= alpha; } }
            float ps = 0.f;
#pragma unroll
            for (int i = 0; i < 16; ++i) { tv[i] = __builtin_amdgcn_exp2f(__builtin_fmaf(sa[i], C1, -mrun)); ps += tv[i]; }
            ps = xsum32(ps);
            lrun += ps;
#pragma unroll
            for (int ks = 0; ks < 2; ++ks) { u32x4 w; w.x = pk2(tv[8 * ks + 0], tv[8 * ks + 1]); w.y = pk2(tv[8 * ks + 2], tv[8 * ks + 3]); w.z = pk2(tv[8 * ks + 4], tv[8 * ks + 5]); w.w = pk2(tv[8 * ks + 6], tv[8 * ks + 7]);
                const bf16x8 pb = __builtin_bit_cast(bf16x8, w);
                O0 = MFMA32(vf[ks], pb, O0); O1 = MFMA32(vf[2 + ks], pb, O1); }
        }
#undef CHUNK_PTRS
        const float inv = 1.0f / lrun;
        bf16_t* op = MIX + (size_t)(row0 + r) * DM + head * 64 + 4 * h;
#pragma unroll
        for (int j = 0; j < 4; ++j) { u32x2 w; w.x = pk2(O0[4 * j] * inv, O0[4 * j + 1] * inv); w.y = pk2(O0[4 * j + 2] * inv, O0[4 * j + 3] * inv); st8(op + 8 * j, w);
            u32x2 w2; w2.x = pk2(O1[4 * j] * inv, O1[4 * j + 1] * inv); w2.y = pk2(O1[4 * j + 2] * inv, O1[4 * j + 3] * inv); st8(op + 32 + 8 * j, w2); }
    }
}

DI void spatial_phase(const Params& p, LAS unsigned char* lds) {
    OPAQUE_IDS();
    unsigned char* ws = p.wsp();
    const bf16_t* UG = (const bf16_t*)(ws + OFF_UG); const bf16_t* V1 = (const bf16_t*)(ws + OFF_V1); const bf16_t* WS = (const bf16_t*)(ws + OFF_WSP);
    const float* rss = (const float*)(ws + OFF_RSS); bf16_t* MIX = (bf16_t*)(ws + OFF_MIX);
    LAS bf16_t* VT = (LAS bf16_t*)lds;
    LAS float* RS = (LAS float*)(lds + 128 * 136 * 2);
    const int tid = tid_o, wid = tid >> 6, lane = tid & 63, h = lane >> 5, r = lane & 31;
    const int tb = wid >> 1, chh = wid & 1;
    for (int task = bid_o; task < 768; task += gdim_o) {
        const int chunk = task >> 3, g = task & 7; const int rowb = chunk * 128;
#pragma unroll
        for (int i = 0; i < 4; ++i) { const int e = tid + NT * i; const int s = e >> 4, c8 = e & 15;
            const u32x4 w = __builtin_nontemporal_load((const u32x4*)(V1 + (size_t)(rowb + s) * 1024 + g * 128 + c8 * 8)); *(LAS u32x4*)(VT + s * 136 + c8 * 8) = w; }
        if (tid < 128) RS[tid] = rsqrtf(rss[rowb + tid] * (1.0f / 1024.0f) + 1e-6f);
        const int t0 = tb * 32, c0 = chh * 64;
        u32x4 wpre[8];
#pragma unroll
        for (int kk = 0; kk < 8; ++kk) wpre[kk] = *(const u32x4*)(WS + (size_t)(g * 128 + t0 + r) * 128 + 16 * kk + 8 * h);
        bf16_t upre[2][16];
#pragma unroll
        for (int i = 0; i < 16; ++i) { const int t = t0 + (i & 3) + 8 * (i >> 2) + 4 * h; const size_t o = (size_t)(rowb + t) * 1024 + g * 128 + c0 + r; upre[0][i] = UG[o]; upre[1][i] = UG[o + 32]; }
        __syncthreads();
        f32x16 a0, a1;
#pragma unroll
        for (int i = 0; i < 16; ++i) { a0[i] = 0.f; a1[i] = 0.f; }
#pragma unroll
        for (int kk = 0; kk < 8; ++kk) {
            const int s0 = 16 * kk + 8 * h;
            const u32x4 wa = wpre[kk];
            float fa[8]; unpack8(wa, fa);
            const f32x4 r0 = *(const LAS f32x4*)(RS + s0), r1 = *(const LAS f32x4*)(RS + s0 + 4);
            fa[0] *= r0[0]; fa[1] *= r0[1]; fa[2] *= r0[2]; fa[3] *= r0[3]; fa[4] *= r1[0]; fa[5] *= r1[1]; fa[6] *= r1[2]; fa[7] *= r1[3];
            const bf16x8 af = __builtin_bit_cast(bf16x8, pack8(fa));
            bf16x8 b0, b1;
#pragma unroll
            for (int j = 0; j < 8; ++j) { b0[j] = (short)VT[(s0 + j) * 136 + c0 + r]; b1[j] = (short)VT[(s0 + j) * 136 + c0 + 32 + r]; }
            a0 = MFMA32(af, b0, a0); a1 = MFMA32(af, b1, a1);
        }
        const float vg0 = p.gmlp_norm_g[g * 128 + c0 + r], vg1 = p.gmlp_norm_g[g * 128 + c0 + 32 + r];
#pragma unroll
        for (int i = 0; i < 16; ++i) { const int t = t0 + (i & 3) + 8 * (i >> 2) + 4 * h; const float bs = p.b_spatial[g * 128 + t];
            const size_t o = (size_t)(rowb + t) * 1024 + g * 128 + c0 + r;
            const float u0 = bflo((unsigned)upre[0][i]), u1 = bflo((unsigned)upre[1][i]);
            MIX[o] = f2bf(u0 * (a0[i] * vg0 + bs)); MIX[o + 32] = f2bf(u1 * (a1[i] * vg1 + bs)); }
        __syncthreads();
    }
}

DI void edge_fixup(const bf16_t* EDGE, bf16_t* ACT, const float* cw  , int pm) {
    OPAQUE_IDS();
    (void)bid_o; (void)gdim_o;
    for (int idx = tid_o; idx < 2 * 352; idx += NT) {
        const int half = idx / 352, cgp = idx - half * 352, j0 = cgp * 8;
        f32x4 a[3][2], b[3][2];
#pragma unroll
        for (int tp = 0; tp < 3; ++tp)
#pragma unroll
            for (int hh = 0; hh < 2; ++hh) { a[tp][hh] = *(const f32x4*)(cw + tp * 5632 + j0 + 4 * hh); b[tp][hh] = *(const f32x4*)(cw + tp * 5632 + 2816 + j0 + 4 * hh); }
        u32x4 gw[4][3], vw[4][3];
        const u32x4 z4 = {0u, 0u, 0u, 0u};
#pragma unroll
        for (int q = 0; q < 4; ++q) {
            const int er = half * 4 + q;
            const int band = pm * 4 + (er >> 1), last = er & 1, row = band * 64 + (last ? 63 : 0);
            const int smask = row < MP ? 255 : 2047;
            const bf16_t *pp, *pc, *pn; bool okp = true, okn = true;
            if (!last) { pc = EDGE + (size_t)(band * 4 + 0) * 5632; pn = EDGE + (size_t)(band * 4 + 1) * 5632; okp = (row & smask) != 0; pp = EDGE + (size_t)((okp ? band - 1 : band) * 4 + 3) * 5632; }
            else { pp = EDGE + (size_t)(band * 4 + 2) * 5632; pc = EDGE + (size_t)(band * 4 + 3) * 5632; okn = ((row + 1) & smask) != 0; pn = EDGE + (size_t)((okn ? band + 1 : band) * 4 + 0) * 5632; }
            gw[q][0] = okp ? *(const u32x4*)(pp + j0) : z4; vw[q][0] = okp ? *(const u32x4*)(pp + 2816 + j0) : z4;
            gw[q][1] = *(const u32x4*)(pc + j0); vw[q][1] = *(const u32x4*)(pc + 2816 + j0);
            gw[q][2] = okn ? *(const u32x4*)(pn + j0) : z4; vw[q][2] = okn ? *(const u32x4*)(pn + 2816 + j0) : z4;
        }
#pragma unroll
        for (int q = 0; q < 4; ++q) {
            const int er = half * 4 + q;
            const int row = (pm * 4 + (er >> 1)) * 64 + ((er & 1) ? 63 : 0);
            float gp[8], gc[8], gn[8], vp[8], vc[8], vn[8], o[8];
            unpack8(gw[q][0], gp); unpack8(gw[q][1], gc); unpack8(gw[q][2], gn); unpack8(vw[q][0], vp); unpack8(vw[q][1], vc); unpack8(vw[q][2], vn);
#pragma unroll
            for (int hh = 0; hh < 2; ++hh)
#pragma unroll
                for (int e = 0; e < 4; ++e) { const int j = 4 * hh + e;
                    const float g = a[0][hh][e] * gp[j] + a[1][hh][e] * gc[j] + a[2][hh][e] * gn[j]; const float v = b[0][hh][e] * vp[j] + b[1][hh][e] * vc[j] + b[2][hh][e] * vn[j];
                    o[j] = silu_f(g) * v; }
            *(u32x4*)(ACT + (size_t)row * 2816 + j0) = pack8(o);
        }
    }
    asm volatile("s_waitcnt vmcnt(0)" ::: "memory");
    __syncthreads();
}

#define XB_TMO      128
#define XB_XCNT(j)  (256  + 64 * (j))
#define XB_XSUB(j)  (1280 + 64 * (j))
#define XB_XGEN(j)  (2304 + 64 * (j))
#define XB_TOP      3328
#define XB_TOPGEN   3392
#define XCD_BAR_WORDS 3456
#define XB_SPIN_CAP (1u << 20)
DI unsigned xb_ld(unsigned* p)              { return __hip_atomic_load(p, __ATOMIC_RELAXED, __HIP_MEMORY_SCOPE_AGENT); }
DI unsigned xb_add(unsigned* p, unsigned v) { return __hip_atomic_fetch_add(p, v, __ATOMIC_RELAXED, __HIP_MEMORY_SCOPE_AGENT); }
DI unsigned xb_xcc_id() { return (unsigned)__builtin_amdgcn_s_getreg((3 << 11) | 20) & 0xFu; }
#define XB_SPIN(cond, bar) do { unsigned _sp = 0; while (cond) { __builtin_amdgcn_s_sleep(1); \
    if ((++_sp & 255u) == 0u) { if (xb_ld(&(bar)[XB_TMO])) break; if (_sp > XB_SPIN_CAP) { atomicAdd(&(bar)[XB_TMO], 1u); break; } } } } while (0)
DI void xcd_barrier_complete(unsigned* bar, unsigned x, unsigned G, unsigned& nloc, unsigned& nx) {
    unsigned sum, cnt, mine, sp = 0u;
    for (;;) {
        sum = 0u; cnt = 0u; mine = 0u;
#pragma unroll
        for (unsigned j = 0; j < 16; ++j) { const unsigned c = xb_ld(&bar[XB_XCNT(j)]); sum += c; cnt += (c > 0u) ? 1u : 0u; mine = (j == x) ? c : mine; }
        if (sum == G) break;
        __builtin_amdgcn_s_sleep(1);
        if ((++sp & 255u) == 0u) { if (xb_ld(&bar[XB_TMO])) break; if (sp > XB_SPIN_CAP) { atomicAdd(&bar[XB_TMO], 1u); break; } }
    }
    nloc = mine > 0u ? mine : 1u; nx = cnt > 0u ? cnt : 1u;
}
DI void xcd_barrier(unsigned* bar, volatile LAS unsigned* st) {
    asm volatile("s_waitcnt vmcnt(0)" ::: "memory");
    __syncthreads();
    if (threadIdx.x == 0) {
        const unsigned x = xb_xcc_id();
        __builtin_amdgcn_s_waitcnt(0);
        unsigned nloc = st[0], nx = st[1];
        if (nloc == 0u) { xcd_barrier_complete(bar, x, gridDim.x, nloc, nx); st[0] = nloc; st[1] = nx; }
        const unsigned old = xb_add(&bar[XB_XSUB(x)], 1u);
        const unsigned gen = old / nloc;
        if (old + 1u == (gen + 1u) * nloc) {
            __builtin_amdgcn_fence(__ATOMIC_RELEASE, "agent");
            asm volatile("s_waitcnt vmcnt(0)" ::: "memory");
            const unsigned og = xb_add(&bar[XB_TOP], 1u);
            const unsigned tg = og / nx;
            if (og + 1u == (tg + 1u) * nx) xb_add(&bar[XB_TOPGEN], 1u);
            else XB_SPIN(xb_ld(&bar[XB_TOPGEN]) == tg, bar);
            __builtin_amdgcn_fence(__ATOMIC_ACQUIRE, "agent");
            xb_add(&bar[XB_XGEN(x)], 1u);
            asm volatile("s_waitcnt vmcnt(0)" ::: "memory");
        } else {
            XB_SPIN(xb_ld(&bar[XB_XGEN(x)]) == gen, bar);
            __builtin_amdgcn_fence(__ATOMIC_ACQUIRE, "agent");
            asm volatile("s_waitcnt vmcnt(0)" ::: "memory");
        }
    }
    __syncthreads();
}

__global__ void __launch_bounds__(NT, 2) mega(KArgs ka) {
    extern __shared__ __attribute__((aligned(16))) unsigned char lds_raw[];
    LAS unsigned char* lds = (LAS unsigned char*)lds_raw;
    cg::grid_group grid = cg::this_grid();
    Params p; p.tab = (LAS unsigned long long*)(lds + PTAB_OFF);
    volatile LAS unsigned* bst = (volatile LAS unsigned*)(lds + PTAB_OFF + 240);
    if (threadIdx.x == 0) {
#pragma unroll
        for (int i = 0; i < 24; ++i) p.tab[i] = (unsigned long long)ka.in[i];
        p.tab[24] = (unsigned long long)ka.out; p.tab[25] = (unsigned long long)ka.ws;
        bst[0] = 0u; bst[1] = 0u;
        (void)xb_add(&((unsigned*)(ka.ws + OFF_BAR))[XB_XCNT(xb_xcc_id())], 1u);
    }
    __syncthreads();
    const int lo = ka.ph_lo, hi = ka.ph_hi;
#define IN(k) (lo <= (k) && (k) < hi)
    if (ka.ph_hi > 1000) grid.sync();
#define SEAM(k) do { if (IN(k) && IN((k) + 1)) xcd_barrier((unsigned*)(p.wsp() + OFF_BAR), bst); } while (0)

    if (IN(0)) for (int rep = 0; rep < REPS(0); ++rep) phase0(p, lds);
    SEAM(0);
    for (int layer = 0; layer < 2; ++layer) {
        if (layer == 0) {
            if (IN(1)) { unsigned char* ws = p.wsp();
                for (int rep = 0; rep < REPS(1); ++rep) modulate_phase(p.x_prompt, p.x_sample, p.norm_mix_g, (const float*)(ws + OFF_MOD), 0, (bf16_t*)(ws + OFF_H));
                tables_phase(p); }
            SEAM(1);
            if (IN(2)) { unsigned char* ws = p.wsp(); float* xo = p.outp();
                Gemm g{(const bf16_t*)(ws + OFF_H), (const bf16_t*)(ws + OFF_WT_IN_EVEN), MROWS, 2304, 1024};
                EpiInEven E{(bf16_t*)(ws + OFF_Q), (bf16_t*)(ws + OFF_KB), (bf16_t*)(ws + OFF_VT), (bf16_t*)(ws + OFF_BCH),
                            xo + (size_t)MROWS * DM, xo + (size_t)MROWS * DM + 524288, p.q_norm_g, p.k_norm_g, (const f32x2*)(ws + OFF_ROPE)};
                for (int rep = 0; rep < REPS(2); ++rep) gemm_phase(lds, g, E);
                bg_run(p, lds, 0);
            }
            SEAM(2);
            if (IN(3)) for (int rep = 0; rep < REPS(3); ++rep) attn_phase(p);
            SEAM(3);
        } else {
            if (IN(7)) { unsigned char* ws = p.wsp();
                Gemm g{(const bf16_t*)(ws + OFF_H), (const bf16_t*)(ws + OFF_WT_IN_ODD), MROWS, 2048, 1024};
                EpiInOdd E{(bf16_t*)(ws + OFF_UG), (bf16_t*)(ws + OFF_V1), (float*)(ws + OFF_RSS), (const float*)(ws + OFF_RSS) + 2 * MROWS, (const float*)(ws + OFF_SW) + 5 * 5632};
                gemm_phase(lds, g, E);
            }
            SEAM(7);
            if (IN(8)) for (int rep = 0; rep < REPS(11); ++rep) spatial_phase(p, lds);
            SEAM(8);
        }
        const int pb = layer == 0 ? 4 : 9;
        if (IN(pb)) { unsigned char* ws = p.wsp(); float* xo = p.outp();
            Gemm g{(const bf16_t*)(ws + OFF_MIX), (const bf16_t*)(ws + (layer == 0 ? OFF_WT_OUT_EVEN : OFF_WT_OUT_ODD)), MROWS, 1024, 1024};
            EpiResid E{p.x_prompt, p.x_sample, layer == 0 ? (const bf16_t*)nullptr : (const bf16_t*)(ws + OFF_XB), xo, (bf16_t*)(ws + OFF_XB),
                       (const float*)(ws + OFF_MOD) + (size_t)layer * 5 * 6144 + 2 * 1024,
                       (bf16_t*)(ws + OFF_H), (const float*)(ws + OFF_GS) + (layer == 0 ? 0 : 2) * 5120, (float*)(ws + OFF_RSS) + (layer == 0 ? 1 : 3) * MROWS};
            gemm_phase(lds, g, E);
            if (layer == 0) bg_run(p, lds, 1);
        }
        SEAM(pb);
        if (IN(pb + 1)) { unsigned char* ws = p.wsp();
            if (layer == 0) gs_l1_phase(p);
            Gemm g{(const bf16_t*)(ws + OFF_H), (const bf16_t*)(ws + OFF_WT_UP + (size_t)layer * SZ_WT_UP), MROWS, 5632, 1024};
            EpiUpConv E{(bf16_t*)(ws + OFF_ACT), (bf16_t*)(ws + OFF_EDGE), p.ffn_conv_w + (size_t)layer * 3 * 5632,
                        (const float*)(ws + OFF_RSS) + (layer == 0 ? 1 : 3) * MROWS, (const float*)(ws + OFF_SW) + (layer == 0 ? 0 : 5 * 7680)};
            gemm_phase(lds, g, E);
            if (layer == 0) bg_run(p, lds, 2);
        }
        SEAM(pb + 1);
        if (IN(pb + 2)) { unsigned char* ws = p.wsp(); float* xo = p.outp();
            { StaticOrder S; S.init(MROWS, 1024, (int)gridDim.x, (int)blockIdx.x); Unit u0;
              for (int i = 0; S.next(i, u0); ++i) edge_fixup((const bf16_t*)(ws + OFF_EDGE), (bf16_t*)(ws + OFF_ACT), p.ffn_conv_w + (size_t)layer * 3 * 5632, u0.pm); }
            Gemm g{(const bf16_t*)(ws + OFF_ACT), (const bf16_t*)(ws + OFF_WT_DOWN + (size_t)layer * SZ_WT_DOWN), MROWS, 1024, 2816};
            EpiResid E{xo, xo, (const bf16_t*)(ws + OFF_XB), xo, layer == 0 ? (bf16_t*)(ws + OFF_XB) : (bf16_t*)nullptr,
                       (const float*)(ws + OFF_MOD) + (size_t)layer * 5 * 6144 + 5 * 1024,
                       layer == 0 ? (bf16_t*)(ws + OFF_H) : (bf16_t*)nullptr, (const float*)(ws + OFF_GS) + 5120, (float*)(ws + OFF_RSS) + 2 * MROWS};
            gemm_phase(lds, g, E);
            if (layer == 0) bg_run(p, lds, 3);
        }
        SEAM(pb + 2);
    }
#undef IN
#undef SEAM
}

constexpr int LDS_TOTAL = LDS_BYTES + 256;
extern "C" void kernel_launch(void* const* d_in, const int* in_sizes, int n_in, void* d_out, int out_size, void* d_ws, size_t ws_size, hipStream_t stream) {
    static int grid = 0;
    if (grid == 0) {
        int dev = 0, cus = 0, per_cu = 0;
        (void)hipGetDevice(&dev);
        (void)hipDeviceGetAttribute(&cus, hipDeviceAttributeMultiprocessorCount, dev);
        if (hipFuncSetAttribute((const void*)mega, hipFuncAttributeMaxDynamicSharedMemorySize, LDS_TOTAL) != hipSuccess) { fprintf(stderr, "hipFuncSetAttribute failed\n"); grid = -1; return; }
        if (hipOccupancyMaxActiveBlocksPerMultiprocessor(&per_cu, (const void*)mega, NT, LDS_TOTAL) != hipSuccess || per_cu < 1) { fprintf(stderr, "occupancy query failed (%d)\n", per_cu); (void)hipGetLastError(); per_cu = 1; }
        if (per_cu > 1) per_cu = 1;
        grid = cus * per_cu;
    }
    if (grid < 0) return;
    KArgs ka{};
    for (int i = 0; i < 24; ++i) ka.in[i] = (const float*)d_in[i];
    ka.out = (float*)d_out; ka.ws = (unsigned char*)d_ws;
    if (hipMemsetAsync((unsigned char*)d_ws + OFF_BAR, 0, BAR_BYTES, stream) != hipSuccess) { fprintf(stderr, "memset failed\n"); return; }
#if COOP
    ka.ph_lo = 0; ka.ph_hi = 12;
    void* args[] = {&ka};
    hipError_t e = hipLaunchCooperativeKernel((const void*)mega, dim3(grid), dim3(NT), args, LDS_TOTAL, stream);
    if (e != hipSuccess) fprintf(stderr, "cooperative launch failed: %s (grid %d)\n", hipGetErrorString(e), grid);
#else
    for (int ph = 0; ph < 12; ++ph) { ka.ph_lo = ph; ka.ph_hi = ph + 1; hipLaunchKernelGGL(mega, dim3(grid), dim3(NT), LDS_TOTAL, stream, ka); }
#endif
}
```
